# Optimizing an MI355X kernel written in HIP

```python
import math
import jax, jax.numpy as jnp
from jax import lax
import numpy as np

D_MODEL = 1024
BATCH = 16
SEQ = 2048
DEPTH = 2

N_HEADS = 16
HEAD_DIM = D_MODEL // N_HEADS
N_MIXERS = 2
CHUNK = 64
LEFT_CHUNKS = 8
BAND = (LEFT_CHUNKS + 1) * CHUNK
REL_CLIP = 128
N_REL = (CHUNK - 1) + REL_CLIP + 1
Q_BLOCK = 128
D_FF = int(math.ceil(D_MODEL * 8 / 3 / 256) * 256)
N_A_LAYERS = (DEPTH + N_MIXERS - 1) // N_MIXERS
RMS_EPS = 1e-6

kernel_name = "hybrid_chunkattn_stickbreak_trunk"


def rms_norm(x, g):
    xf = x.astype(jnp.float32)
    y = xf * lax.rsqrt(jnp.mean(xf * xf, axis=-1, keepdims=True) + RMS_EPS)
    return (y * g.astype(jnp.float32)).astype(x.dtype)


def split_heads(h, w_qkv):
    b, s, _ = h.shape
    qkv = (h @ w_qkv).reshape(b, s, 3, N_HEADS, HEAD_DIM)
    qkv = jnp.transpose(qkv, (2, 0, 3, 1, 4))
    return qkv[0], qkv[1], qkv[2]


def merge_heads(o):
    b, h, s, d = o.shape
    return jnp.transpose(o, (0, 2, 1, 3)).reshape(b, s, h * d)


def chunk_relpos_attention(h, w_qkv, w_o, rel_bias):
    b, s, _ = h.shape
    n_chunks = s // CHUNK
    q, k, v = split_heads(h, w_qkv)
    i_idx = np.arange(CHUNK)[:, None]
    j_idx = np.arange(BAND)[None, :]
    rel = np.clip(LEFT_CHUNKS * CHUNK + i_idx - j_idx, -(CHUNK - 1), REL_CLIP) + (CHUNK - 1)
    bias = jnp.take(rel_bias, jnp.asarray(rel, dtype=jnp.int32), axis=1).astype(jnp.float32)
    scale = 1.0 / math.sqrt(HEAD_DIM)
    outs = []
    for c in range(n_chunks):
        k0 = max(0, (c - LEFT_CHUNKS) * CHUNK)
        k1 = (c + 1) * CHUNK
        n_keys = k1 - k0
        q_blk = q[:, :, c * CHUNK:(c + 1) * CHUNK]
        sc = jnp.einsum('bhqd,bhkd->bhqk', q_blk, k[:, :, k0:k1]).astype(jnp.float32) * scale
        sc = sc + bias[None, :, :, BAND - n_keys:]
        p = jax.nn.softmax(sc, axis=-1).astype(v.dtype)
        outs.append(jnp.einsum('bhqk,bhkd->bhqd', p, v[:, :, k0:k1]))
    o = jnp.concatenate(outs, axis=2)
    return merge_heads(o) @ w_o


def stick_breaking_attention(h, w_qkv, w_o):
    b, s, _ = h.shape
    q, k, v = split_heads(h, w_qkv)
    scale = 1.0 / math.sqrt(HEAD_DIM)
    outs = []
    for qb in range(s // Q_BLOCK):
        n_keys = (qb + 1) * Q_BLOCK
        q_blk = q[:, :, qb * Q_BLOCK:(qb + 1) * Q_BLOCK]
        z = jnp.einsum('bhqd,bhkd->bhqk', q_blk, k[:, :, :n_keys]).astype(jnp.float32) * scale
        t_pos = qb * Q_BLOCK + np.arange(Q_BLOCK)
        causal = jnp.asarray((np.arange(n_keys)[None, :] < t_pos[:, None])[None, None])
        log_keep = jnp.where(causal, jax.nn.log_sigmoid(-z), 0.0)
        suffix = lax.cumsum(log_keep, axis=3, reverse=True) - log_keep
        a = jnp.where(causal, jnp.exp(jax.nn.log_sigmoid(z) + suffix), 0.0).astype(v.dtype)
        outs.append(jnp.einsum('bhqk,bhkd->bhqd', a, v[:, :, :n_keys]))
    o = jnp.concatenate(outs, axis=2)
    return merge_heads(o) @ w_o


def swiglu(h, w_gate, w_up, w_down):
    return (jax.nn.silu(h @ w_gate) * (h @ w_up)) @ w_down


def setup_inputs(seed: int = 0) -> dict:
    key = jax.random.key(seed)
    ks = jax.random.split(key, 12)
    d, f = D_MODEL, D_FF
    nrm = lambda k, shape, fan: jax.random.normal(k, shape, jnp.float32) * (fan ** -0.5)
    gain = lambda k: 1.0 + 0.02 * jax.random.normal(k, (DEPTH, d), jnp.float32)
    return {
        "x": jax.random.normal(ks[0], (BATCH, SEQ, d), jnp.float32),
        "g_pre_mix": gain(ks[1]),
        "g_post_mix": gain(ks[2]),
        "w_qkv": nrm(ks[3], (DEPTH, d, 3 * d), d),
        "w_o": nrm(ks[4], (DEPTH, d, d), d),
        "rel_bias": 0.5 * jax.random.normal(ks[5], (N_A_LAYERS, N_HEADS, N_REL), jnp.float32),
        "g_pre_ffn": gain(ks[6]),
        "g_post_ffn": gain(ks[7]),
        "w_gate": nrm(ks[8], (DEPTH, d, f), d),
        "w_up": nrm(ks[9], (DEPTH, d, f), d),
        "w_down": nrm(ks[10], (DEPTH, f, d), f),
    }


def reference(x, g_pre_mix, g_post_mix, w_qkv, w_o, rel_bias, g_pre_ffn, g_post_ffn, w_gate, w_up, w_down):
    for i in range(DEPTH):
        h = rms_norm(x, g_pre_mix[i])
        if i % N_MIXERS == 0:
            m = chunk_relpos_attention(h, w_qkv[i], w_o[i], rel_bias[i // N_MIXERS])
        else:
            m = stick_breaking_attention(h, w_qkv[i], w_o[i])
        x = x + rms_norm(m, g_post_mix[i])
        h = rms_norm(x, g_pre_ffn[i])
        x = x + rms_norm(swiglu(h, w_gate[i], w_up[i], w_down[i]), g_post_ffn[i])
    return x
```

```cpp
#include <hip/hip_runtime.h>
#include <hip/hip_cooperative_groups.h>
#include <cstdio>
#include <cstdint>
namespace cg = cooperative_groups;
#define LAS __attribute__((address_space(3)))
namespace pg8 {
#define PG8_LAS __attribute__((address_space(3)))
typedef unsigned short bf16_t;
typedef short bf16x8 __attribute__((ext_vector_type(8)));
typedef float f32x4 __attribute__((ext_vector_type(4)));
typedef unsigned u32x4 __attribute__((ext_vector_type(4)));
constexpr int BM = 256, BK = 64, HALF = 128, HTB = HALF * BK * 2  , STAGE_BYTES = 8 * HTB, NXCD = 8, WGM = 4;

__host__ __device__ __forceinline__ int lds_byte(int r, int c) { const int st = (r >> 4) * 2 + (c >> 5), rr = r & 15, cc = c & 31, ob = rr * 64 + cc * 2; return st * 1024 + (ob ^ (((ob >> 9) & 1) << 5)); }
__host__ __device__ __forceinline__ void stage_rc(int b, int& R, int& C) { const int st = b / 1024, sb = b % 1024, swz = sb ^ (((sb >> 9) & 1) << 5); R = (st >> 1) * 16 + swz / 64; C = (st & 1) * 32 + (swz % 64) / 2; }
__host__ __device__ __forceinline__ int perm32(int rho) { const int n = rho >> 4, i = rho & 15; return 8 * (i >> 2) + 4 * n + (i & 3); }

struct Unit { int pm, pn; };
struct Gemm { const bf16_t* A; const bf16_t* Bt; int M, N, K; };

struct StaticOrder {
    int nM, nN, nwg, G, c;
    __host__ __device__ void init(int M, int N, int G_, int c_) { nM = M / BM; nN = N / BM; nwg = nM * nN; G = G_; c = c_; }
    __host__ __device__ bool next(int i, Unit& u) const {
        const long L = (long)i * G + c; if (L >= nwg) return false;
        int wgid = (int)L; { const int q = nwg / NXCD, r = nwg % NXCD, xcd = wgid % NXCD, off = wgid / NXCD; wgid = (xcd < r ? xcd * (q + 1) : r * (q + 1) + (xcd - r) * q) + off; }
        const int nig = WGM * nN, gid = wgid / nig, fm = gid * WGM, gsz = (nM - fm) < WGM ? (nM - fm) : WGM;
        u.pm = fm + ((wgid % nig) % gsz); u.pn = (wgid % nig) / gsz; return true;
    }
    __device__ __forceinline__ void a_ready(const Unit&) const {}
    __device__ __forceinline__ void done(const Unit&) const {}
};

__device__ __forceinline__ unsigned cvt_pk_bf16(float lo, float hi) { unsigned r; asm volatile("v_cvt_pk_bf16_f32 %0, %1, %2" : "=v"(r) : "v"(lo), "v"(hi)); return r; }
typedef float f32x2 __attribute__((ext_vector_type(2)));
__device__ __forceinline__ f32x2 gelu_pk(f32x2 v) {
    const f32x2 av = __builtin_elementwise_abs(v), d = av * 0.2316418882f + 1.0f;
    f32x2 t; t.x = __builtin_amdgcn_rcpf(d.x); t.y = __builtin_amdgcn_rcpf(d.y);
    f32x2 q = t * 0.5307027145f + (-0.7265760135f); q = q * t + 0.7107068705f; q = q * t + (-0.142248368f); q = q * t + 0.127414796f; q = q * t;
    const f32x2 s = (v * v) * (-0.72134752044f);
    f32x2 e; e.x = __builtin_amdgcn_exp2f(s.x); e.y = __builtin_amdgcn_exp2f(s.y);
    const f32x2 m = v * (q * e), r = v - m;
    f32x2 o; o.x = v.x < 0.f ? m.x : r.x; o.y = v.y < 0.f ? m.y : r.y; return o;
}

template <int ACT  > struct EpiBf16 {
    static constexpr bool PERM = true, AFTER_DRAIN = false; static_assert(ACT == 0 || ACT == 1, "EpiBf16: ACT is 0 (none) or 1 (gelu_pk)");
    bf16_t* O; int ldc; const float* bias; int split_cols; size_t split_stride; float scale0;
    __device__ __forceinline__ void operator()(const f32x4 (&acc)[2][2][4][2], const Unit& u, int wr, int wc, int fr, int fq) const {
        const int row0 = u.pm * BM + wr * 64 + fr; int colt = u.pn * BM; bf16_t* base = O;
        float sc = 1.f; if (split_cols) { const int t = colt / split_cols; base += (size_t)t * split_stride; colt -= t * split_cols; if (t == 0) sc = scale0; }
        const int col0 = colt + wc * 32 + 8 * fq, bcol0 = u.pn * BM + wc * 32 + 8 * fq;
        f32x4 bv[2][2];
#pragma unroll
        for (int bj = 0; bj < 2; ++bj)
#pragma unroll
            for (int n = 0; n < 2; ++n) bv[bj][n] = bias ? *(const f32x4*)(bias + bcol0 + bj * HALF + 4 * n) : (f32x4){0.f, 0.f, 0.f, 0.f};
#pragma unroll
        for (int ai = 0; ai < 2; ++ai)
#pragma unroll
            for (int m = 0; m < 4; ++m) { bf16_t* rowp = base + (size_t)(row0 + ai * HALF + m * 16) * ldc + col0;
#pragma unroll
                for (int bj = 0; bj < 2; ++bj) { f32x4 v0 = acc[ai][bj][m][0] + bv[bj][0], v1 = acc[ai][bj][m][1] + bv[bj][1];
                    if (ACT == 1) { f32x2 a = gelu_pk((f32x2){v0[0], v0[1]}), b = gelu_pk((f32x2){v0[2], v0[3]}), c = gelu_pk((f32x2){v1[0], v1[1]}), d = gelu_pk((f32x2){v1[2], v1[3]});
                        v0 = (f32x4){a.x, a.y, b.x, b.y}; v1 = (f32x4){c.x, c.y, d.x, d.y}; }
                    v0 = v0 * sc; v1 = v1 * sc; u32x4 w; w.x = cvt_pk_bf16(v0[0], v0[1]); w.y = cvt_pk_bf16(v0[2], v0[3]); w.z = cvt_pk_bf16(v1[0], v1[1]); w.w = cvt_pk_bf16(v1[2], v1[3]);
                    *(u32x4*)(rowp + bj * HALF) = w; } }
    }
};
template <class Epi, class Sched, bool ALIGN_EPI = false, bool SP2 = false>
__device__ __forceinline__ void gemm_phase(PG8_LAS unsigned char* lds, const Gemm g, const Sched& S, const Epi& E) {
    int tid_ = threadIdx.x; asm volatile("" : "+v"(tid_));
    const int tid = tid_, wid = __builtin_amdgcn_readfirstlane(tid >> 6), lane = tid & 63, wr = wid >> 2, wc = wid & 3, fr = lane & 15, fq = lane >> 4;
    const int K = g.K, nt = K / BK;
    unsigned voffA[2], voffB[2];
#pragma unroll
    for (int i = 0; i < 2; ++i) { int R, C; stage_rc(tid * 16 + i * 8192, R, C); const int Rb = Epi::PERM ? ((R & ~31) + perm32(R & 31)) : R;
        voffA[i] = (unsigned)(R * K + C) * 2u; voffB[i] = (unsigned)(Rb * K + C) * 2u; }
    const size_t kstep = (size_t)(BK * 2);
    const size_t hstep = (size_t)HALF * K * 2;
    const size_t tstep = 2 * hstep;
    const unsigned ldsw = (unsigned)wid * 1024u;
    const int aoff = lds_byte(wr * 64 + fr, fq * 8), boff = lds_byte(wc * 32 + fr, fq * 8);
#define PG8_SA(b, h) (((b) * 2 + (h)) * HTB)
#define PG8_SB(b, h) ((4 + (b) * 2 + (h)) * HTB)
#define PG8_STAGE(bufoff, gbase, voff) do { _Pragma("unroll") for (int _i = 0; _i < 2; ++_i) \
        __builtin_amdgcn_global_load_lds((const unsigned*)((const char*)(gbase) + (voff)[_i]), (PG8_LAS unsigned*)(lds + (bufoff) + ldsw + _i * 8192), 16, 0, 0); } while (0)
#define PG8_LDA(dst, b, h) do { _Pragma("unroll") for (int m = 0; m < 4; ++m) _Pragma("unroll") for (int k = 0; k < 2; ++k) dst[m][k] = *(const PG8_LAS bf16x8*)(lds + PG8_SA(b, h) + aoff + m * 2048 + k * 1024); } while (0)
#define PG8_LDB(dst, b, h) do { _Pragma("unroll") for (int n = 0; n < 2; ++n) _Pragma("unroll") for (int k = 0; k < 2; ++k) dst[n][k] = *(const PG8_LAS bf16x8*)(lds + PG8_SB(b, h) + boff + n * 2048 + k * 1024); } while (0)
#define PG8_MMA(ai, bj, At, Bt) do { __builtin_amdgcn_s_setprio(1); _Pragma("unroll") for (int m = 0; m < 4; ++m) _Pragma("unroll") for (int n = 0; n < 2; ++n) _Pragma("unroll") for (int k = 0; k < 2; ++k) \
        acc[ai][bj][m][n] = __builtin_amdgcn_mfma_f32_16x16x32_bf16(Bt[n][k], At[m][k], acc[ai][bj][m][n], 0, 0, 0); __builtin_amdgcn_s_setprio(0); } while (0)
#define PG8_WAIT_V(n) asm volatile("s_waitcnt vmcnt(" #n ")" ::: "memory")
#define PG8_WAIT_L(n) asm volatile("s_waitcnt lgkmcnt(" #n ")" ::: "memory")
#define PG8_BAR __builtin_amdgcn_s_barrier()
#define PG8_SCHED __builtin_amdgcn_sched_barrier(0)
    Unit cur, nxt; int ui = 0;
    if (!S.next(0, cur)) return;
    f32x4 acc[2][2][4][2];
#pragma unroll
    for (int a = 0; a < 2; ++a)
#pragma unroll
        for (int b = 0; b < 2; ++b)
#pragma unroll
            for (int m = 0; m < 4; ++m)
#pragma unroll
                for (int n = 0; n < 2; ++n) acc[a][b][m][n] = (f32x4){0.f, 0.f, 0.f, 0.f};
    bf16x8 At[4][2], B0[2][2], B1[2][2];
    const char* cA = (const char*)g.A + (size_t)cur.pm * tstep; const char* cB = (const char*)g.Bt + (size_t)cur.pn * tstep;
    S.a_ready(cur);
    if constexpr (SP2) {
        PG8_STAGE(PG8_SB(0, 0), cB, voffB); PG8_STAGE(PG8_SB(0, 1), cB + hstep, voffB); PG8_STAGE(PG8_SA(0, 0), cA, voffA); PG8_STAGE(PG8_SA(0, 1), cA + hstep, voffA);
        if (wr == 1) PG8_BAR;
        PG8_WAIT_V(2); PG8_BAR;
        PG8_STAGE(PG8_SB(1, 0), cB + kstep, voffB); PG8_STAGE(PG8_SA(1, 0), cA + kstep, voffA); PG8_STAGE(PG8_SB(1, 1), cB + hstep + kstep, voffB);
        PG8_WAIT_V(6); PG8_BAR;
    } else {
        PG8_STAGE(PG8_SB(0, 0), cB, voffB); PG8_STAGE(PG8_SA(0, 0), cA, voffA); PG8_STAGE(PG8_SB(0, 1), cB + hstep, voffB); PG8_STAGE(PG8_SA(0, 1), cA + hstep, voffA);
        if (wr == 1) PG8_BAR;
        PG8_WAIT_V(4); PG8_BAR;
        PG8_STAGE(PG8_SB(1, 0), cB + kstep, voffB); PG8_STAGE(PG8_SA(1, 0), cA + kstep, voffA); PG8_STAGE(PG8_SB(1, 1), cB + hstep + kstep, voffB);
        PG8_WAIT_V(6); PG8_BAR;
    }
    for (;;) {
        const bool has_next = S.next(ui + 1, nxt);
        const char* nA = has_next ? (const char*)g.A + (size_t)nxt.pm * tstep : cA; const char* nB = has_next ? (const char*)g.Bt + (size_t)nxt.pn * tstep : cB;
        for (int t = 0; t < nt; t += 2) {
            const bool last = (t == nt - 2);
            const char* a1 = cA + (size_t)(t + 1) * kstep;
            const char* a2 = last ? nA : cA + (size_t)(t + 2) * kstep; const char* b2 = last ? nB : cB + (size_t)(t + 2) * kstep;
            const char* a3 = a2 + kstep; const char* b3 = b2 + kstep;
            if (last && has_next) S.a_ready(nxt);
            if constexpr (SP2) {
            PG8_LDB(B0, 0, 0); PG8_LDB(B1, 0, 1); PG8_SCHED; PG8_LDA(At, 0, 0); PG8_STAGE(PG8_SA(1, 1), a1 + hstep, voffA);
            PG8_WAIT_V(8); PG8_WAIT_L(0); PG8_BAR; PG8_MMA(0, 0, At, B0); PG8_MMA(0, 1, At, B1); PG8_BAR; PG8_SCHED;
            PG8_LDA(At, 0, 1); PG8_STAGE(PG8_SB(0, 0), b2, voffB); PG8_STAGE(PG8_SB(0, 1), b2 + hstep, voffB); PG8_STAGE(PG8_SA(0, 0), a2, voffA);
            PG8_WAIT_V(8); PG8_WAIT_L(0); PG8_BAR; PG8_MMA(1, 0, At, B0); PG8_MMA(1, 1, At, B1); PG8_BAR; PG8_SCHED;
            PG8_LDB(B0, 1, 0); PG8_LDB(B1, 1, 1); PG8_SCHED; PG8_LDA(At, 1, 0); PG8_STAGE(PG8_SA(0, 1), a2 + hstep, voffA);
            PG8_WAIT_V(8); PG8_WAIT_L(0); PG8_BAR; PG8_MMA(0, 0, At, B0); PG8_MMA(0, 1, At, B1); PG8_BAR; PG8_SCHED;
            PG8_LDA(At, 1, 1); PG8_STAGE(PG8_SB(1, 0), b3, voffB); PG8_STAGE(PG8_SB(1, 1), b3 + hstep, voffB); PG8_STAGE(PG8_SA(1, 0), a3, voffA);
            PG8_WAIT_V(8); PG8_WAIT_L(0); PG8_BAR; PG8_MMA(1, 0, At, B0); PG8_MMA(1, 1, At, B1); PG8_BAR; PG8_SCHED;
            } else {
            PG8_LDB(B0, 0, 0); PG8_SCHED; PG8_LDA(At, 0, 0); PG8_STAGE(PG8_SA(1, 1), a1 + hstep, voffA);
            PG8_WAIT_L(8); PG8_BAR; PG8_WAIT_L(0); PG8_MMA(0, 0, At, B0); PG8_BAR; PG8_SCHED;
            PG8_LDB(B1, 0, 1); PG8_STAGE(PG8_SB(0, 0), b2, voffB);
            PG8_BAR; PG8_WAIT_L(0); PG8_MMA(0, 1, At, B1); PG8_BAR;
            PG8_LDA(At, 0, 1); PG8_STAGE(PG8_SA(0, 0), a2, voffA);
            PG8_BAR; PG8_WAIT_L(0); PG8_MMA(1, 0, At, B0); PG8_BAR; PG8_SCHED;
            PG8_STAGE(PG8_SB(0, 1), b2 + hstep, voffB);
            PG8_WAIT_V(6); PG8_BAR; PG8_MMA(1, 1, At, B1); PG8_BAR;
            PG8_LDB(B0, 1, 0); PG8_SCHED; PG8_LDA(At, 1, 0); PG8_STAGE(PG8_SA(0, 1), a2 + hstep, voffA);
            PG8_WAIT_L(8); PG8_BAR; PG8_WAIT_L(0); PG8_MMA(0, 0, At, B0); PG8_BAR; PG8_SCHED;
            PG8_LDB(B1, 1, 1); PG8_STAGE(PG8_SB(1, 0), b3, voffB);
            PG8_BAR; PG8_WAIT_L(0); PG8_MMA(0, 1, At, B1); PG8_BAR;
            PG8_LDA(At, 1, 1); PG8_STAGE(PG8_SA(1, 0), a3, voffA);
            PG8_BAR; PG8_WAIT_L(0); PG8_MMA(1, 0, At, B0); PG8_BAR; PG8_SCHED;
            PG8_STAGE(PG8_SB(1, 1), b3 + hstep, voffB);
            PG8_WAIT_V(6); PG8_BAR; PG8_MMA(1, 1, At, B1); PG8_BAR;
            }
        }
        if constexpr (ALIGN_EPI) { if (wr == 0) PG8_BAR; }
        if constexpr (!Epi::AFTER_DRAIN) { E(acc, cur, wr, wc, fr, fq); S.done(cur); }
        if (!has_next) break;
#pragma unroll
        for (int a = 0; a < 2; ++a)
#pragma unroll
            for (int b = 0; b < 2; ++b)
#pragma unroll
                for (int m = 0; m < 4; ++m)
#pragma unroll
                    for (int n = 0; n < 2; ++n) acc[a][b][m][n] = (f32x4){0.f, 0.f, 0.f, 0.f};
        cur = nxt; cA = nA; cB = nB; ++ui;
        if constexpr (ALIGN_EPI) { if (wr == 1) PG8_BAR; }
    }
    PG8_WAIT_V(0);
    if constexpr (!ALIGN_EPI) { if (wr == 0) PG8_BAR; }
    PG8_BAR;
    if constexpr (Epi::AFTER_DRAIN) { E.fused(acc, cur, wr, wc, fr, fq, lds, wid, lane); S.done(cur); }
#undef PG8_SA
#undef PG8_SB
#undef PG8_STAGE
#undef PG8_LDA
#undef PG8_LDB
#undef PG8_MMA
#undef PG8_WAIT_V
#undef PG8_WAIT_L
#undef PG8_BAR
#undef PG8_SCHED
}
}
#define XB_TMO      128
#define XB_XCNT(j)  (256  + 64 * (j))
#define XB_XSUB(j)  (1280 + 64 * (j))
#define XB_XGEN(j)  (2304 + 64 * (j))
#define XB_TOP      3328
#define XB_TOPGEN   3392
#define XCD_BAR_WORDS 3456
#define XB_SPIN_CAP (1u << 18)

__device__ __forceinline__ unsigned xb_ld(unsigned* p)              { return __hip_atomic_load(p, __ATOMIC_RELAXED, __HIP_MEMORY_SCOPE_AGENT); }
__device__ __forceinline__ unsigned xb_add(unsigned* p, unsigned v) { return __hip_atomic_fetch_add(p, v, __ATOMIC_RELAXED, __HIP_MEMORY_SCOPE_AGENT); }
__device__ __forceinline__ unsigned xb_xcc_id() { return (unsigned)__builtin_amdgcn_s_getreg((3 << 11) | 20) & 0xFu; }
#define XB_SPIN(cond, bar) do { unsigned _sp = 0; while (cond) { __builtin_amdgcn_s_sleep(1); \
    if ((++_sp & 255u) == 0u) { if (xb_ld(&(bar)[XB_TMO])) break; if (_sp > XB_SPIN_CAP) { atomicAdd(&(bar)[XB_TMO], 1u); break; } } } } while (0)

struct XcdBarrier {
    unsigned* bar; unsigned x;
    volatile LAS unsigned* st;
};

__device__ __forceinline__ XcdBarrier xcd_barrier_post(unsigned* bar, volatile LAS unsigned* st) {
    XcdBarrier b; b.bar = bar; b.x = xb_xcc_id(); b.st = st;
    if (threadIdx.x == 0) (void)xb_add(&bar[XB_XCNT(b.x)], 1u);
    return b;
}
__device__ __forceinline__ void xcd_barrier_complete(unsigned* bar, unsigned x, unsigned& nloc, unsigned& nx) {
    const unsigned G = gridDim.x * gridDim.y * gridDim.z;
    unsigned sum, cnt, mine, sp = 0u;
    for (;;) {
        sum = 0u; cnt = 0u; mine = 0u;
#pragma unroll
        for (unsigned j = 0; j < 16; ++j) { const unsigned c = xb_ld(&bar[XB_XCNT(j)]); sum += c; cnt += (c > 0u) ? 1u : 0u; mine = (j == x) ? c : mine; }
        if (sum == G) break;
        __builtin_amdgcn_s_sleep(1);
        if ((++sp & 255u) == 0u) { if (xb_ld(&bar[XB_TMO])) break; if (sp > XB_SPIN_CAP) { atomicAdd(&bar[XB_TMO], 1u); break; } }
    }
    nloc = mine > 0u ? mine : 1u; nx = cnt > 0u ? cnt : 1u;
}

__device__ __forceinline__ void xcd_barrier(const XcdBarrier& b) {
    asm volatile("s_waitcnt vmcnt(0)" ::: "memory");
    __syncthreads();
    if (threadIdx.x == 0) {
        unsigned* bar = b.bar;
        __builtin_amdgcn_s_waitcnt(0);
        unsigned nloc = b.st[0], nx = b.st[1];
        if (nloc == 0u) { xcd_barrier_complete(bar, b.x, nloc, nx); b.st[0] = nloc; b.st[1] = nx; }
        const unsigned old = xb_add(&bar[XB_XSUB(b.x)], 1u);
        const unsigned gen = old / nloc;
        if (old + 1u == (gen + 1u) * nloc) {
            __builtin_amdgcn_fence(__ATOMIC_RELEASE, "agent");
            asm volatile("s_waitcnt vmcnt(0)" ::: "memory");
            const unsigned og = xb_add(&bar[XB_TOP], 1u);
            const unsigned tg = og / nx;
            if (og + 1u == (tg + 1u) * nx) xb_add(&bar[XB_TOPGEN], 1u);
            else XB_SPIN(xb_ld(&bar[XB_TOPGEN]) == tg, bar);
            __builtin_amdgcn_fence(__ATOMIC_ACQUIRE, "agent");
            xb_add(&bar[XB_XGEN(b.x)], 1u);
            asm volatile("s_waitcnt vmcnt(0)" ::: "memory");
        } else {
            XB_SPIN(xb_ld(&bar[XB_XGEN(b.x)]) == gen, bar);
            __builtin_amdgcn_fence(__ATOMIC_ACQUIRE, "agent");
            asm volatile("s_waitcnt vmcnt(0)" ::: "memory");
        }
    }
    __syncthreads();
}

#ifndef MK_DUP
#define MK_DUP 0
#endif
#ifndef MK_SGB
#define MK_SGB 0
#endif
#ifndef MK_SKEW0
#define MK_SKEW0 0
#define MK_SKEW1 0
#endif
#ifndef MK_MULTI
#define MK_MULTI 0
#endif
constexpr int BATCH = 16, SEQ = 2048, D = 1024, H = 16, HD = 64, FF = 2816, DEPTH = 2, NREL = 192;
constexpr int M = BATCH * SEQ;
constexpr float RMS_EPS = 1e-6f;
constexpr float LOG2E = 1.4426950408889634f;
constexpr float C2 = 0.125f * LOG2E;
constexpr int NPH = 1 + 7 * DEPTH;
constexpr size_t MiB = 1u << 20;
constexpr size_t W_LAYER = 25 * MiB;
constexpr size_t W_QKV = 0, W_O = 6 * MiB, W_13 = 8 * MiB, W_2 = 19 * MiB;
constexpr size_t WS_XN = 64 * MiB, WS_Q = 128 * MiB, WS_K = 192 * MiB, WS_VT = 256 * MiB, WS_O = 320 * MiB, WS_MB = 384 * MiB, WS_END = 448 * MiB;
constexpr size_t WS_H = WS_Q;
static_assert(W_LAYER * DEPTH <= WS_XN && (size_t)M * FF * 2 <= WS_O - WS_H, "d_ws map");
constexpr size_t WS_CTL = 56 * MiB;
constexpr int MISC_OFF = 131072, LDS_BYTES = 131072 + 256;

typedef pg8::bf16_t bf16_t;
typedef short bf16x8 __attribute__((ext_vector_type(8)));
typedef float f32x16 __attribute__((ext_vector_type(16)));
typedef float f32x4 __attribute__((ext_vector_type(4)));
typedef unsigned u32x4 __attribute__((ext_vector_type(4)));
typedef unsigned u32x2 __attribute__((ext_vector_type(2)));

__device__ __forceinline__ unsigned cvtpk(float lo, float hi) { typedef float f2 __attribute__((ext_vector_type(2))); typedef __bf16 b2 __attribute__((ext_vector_type(2)));
    f2 v = {lo, hi}; b2 b = __builtin_convertvector(v, b2); return __builtin_bit_cast(unsigned, b); }
__device__ __forceinline__ float bflo(unsigned w) { return __uint_as_float(w << 16); }
__device__ __forceinline__ float bfhi(unsigned w) { return __uint_as_float(w & 0xffff0000u); }
__device__ __forceinline__ float wave_sum(float v) {
#pragma unroll
    for (int o = 1; o < 64; o <<= 1) v += __shfl_xor(v, o);
    return v;
}
__device__ __forceinline__ float ex2(float v) { return __builtin_amdgcn_exp2f(v); }
__device__ __forceinline__ float lg2(float v) { return __builtin_amdgcn_logf(v); }

struct EpiSwiGLU {
    static constexpr bool PERM = true, AFTER_DRAIN = false;
    bf16_t* O; int ldc;
    __device__ __forceinline__ void operator()(const pg8::f32x4 (&acc)[2][2][4][2], const pg8::Unit& u, int wr, int wc, int fr, int fq) const {
        const int row0 = u.pm * pg8::BM + wr * 64 + fr, col0 = u.pn * pg8::HALF + wc * 32 + 8 * fq;
#pragma unroll
        for (int ai = 0; ai < 2; ++ai)
#pragma unroll
            for (int m = 0; m < 4; ++m) {
                bf16_t* rowp = O + (size_t)(row0 + ai * pg8::HALF + m * 16) * ldc + col0;
                float hv[8];
#pragma unroll
                for (int n = 0; n < 2; ++n)
#pragma unroll
                    for (int t = 0; t < 4; ++t) { const float g = acc[ai][0][m][n][t], up = acc[ai][1][m][n][t];
                        hv[4 * n + t] = g * __builtin_amdgcn_rcpf(1.0f + ex2(-g * LOG2E)) * up; }
                u32x4 w; w.x = cvtpk(hv[0], hv[1]); w.y = cvtpk(hv[2], hv[3]); w.z = cvtpk(hv[4], hv[5]); w.w = cvtpk(hv[6], hv[7]);
                *(u32x4*)rowp = w;
            }
    }
};

struct GuOrder : pg8::StaticOrder {
    __device__ bool next(int i, pg8::Unit& u) const {
        if (G != 256) return pg8::StaticOrder::next(i, u);
        const int L = i * G + c; if (L >= nwg) return false;
        const int xcd = L & 7, off = L >> 3;
        int pl, pn;
        if (off < 256) { const int ch = off >> 7, o = off & 127; pl = 4 * (o >> 5) + (o & 3); pn = 8 * ch + ((o & 31) >> 2); }
        else { const int o = off - 256; pl = 4 * (o / 24) + (o % 24) % 4; pn = 16 + (o % 24) / 4; }
        u.pm = 16 * xcd + pl; u.pn = pn; return true;
    }
};
__device__ __forceinline__ void transpose_item(const float* W, int K, int N, bf16_t* WT, int k0, int n0, int dst_row0, LAS float* scr, int lane) {
    float wv[32];
#pragma unroll
    for (int i = 0; i < 32; ++i) wv[i] = __builtin_nontemporal_load(W + (size_t)(k0 + 2 * i + (lane >> 5)) * N + n0 + (lane & 31));
#pragma unroll
    for (int i = 0; i < 32; ++i) scr[(2 * i + (lane >> 5)) * 33 + (lane & 31)] = wv[i];
    asm volatile("s_waitcnt lgkmcnt(0)" ::: "memory");
    const int c = lane & 7;
#pragma unroll
    for (int j = 0; j < 4; ++j) { const int n = (lane >> 3) + 8 * j; const LAS float* s = scr + (8 * c) * 33 + n;
        u32x4 o; o.x = cvtpk(s[0 * 33], s[1 * 33]); o.y = cvtpk(s[2 * 33], s[3 * 33]); o.z = cvtpk(s[4 * 33], s[5 * 33]); o.w = cvtpk(s[6 * 33], s[7 * 33]);
        *(u32x4*)(WT + (size_t)(dst_row0 + n) * K + k0 + 8 * c) = o; }
    asm volatile("s_waitcnt lgkmcnt(0)" ::: "memory");
}

#define RP_SS(v) ((v.x * v.x + v.y * v.y) + (v.z * v.z + v.w * v.w))
#define RP_DEC(w) ((f32x4){bflo(w.x), bfhi(w.x), bflo(w.y), bfhi(w.y)})
__device__ __forceinline__ void row_phase(const float* xin, const bf16_t* mA, const float* gA, const bf16_t* mB, const float* gB, float* xout, bf16_t* xn, const float* gq_, int gw, int ngw, int lane) {
    asm volatile("" : "+v"(lane));
    const f32x4 z4 = {0.f, 0.f, 0.f, 0.f};
    f32x4 ga[4], gb[4], gq[4];
#pragma unroll
    for (int j = 0; j < 4; ++j) { ga[j] = mA ? *((const f32x4*)gA + lane + 64 * j) : z4; gb[j] = mB ? *((const f32x4*)gB + lane + 64 * j) : z4; gq[j] = xn ? *((const f32x4*)gq_ + lane + 64 * j) : z4; }
    int row = gw;
    for (; row + ngw < M; row += 2 * ngw) {
        const size_t o0 = (size_t)row * D, o1 = (size_t)(row + ngw) * D;
        f32x4 va[4], vb[4]; u32x2 wa[4], wb[4], ya[4], yb[4];
#pragma unroll
        for (int j = 0; j < 4; ++j) { va[j] = __builtin_nontemporal_load((const f32x4*)(xin + o0) + lane + 64 * j); vb[j] = __builtin_nontemporal_load((const f32x4*)(xin + o1) + lane + 64 * j); }
        if (mA) {
#pragma unroll
            for (int j = 0; j < 4; ++j) { wa[j] = __builtin_nontemporal_load((const u32x2*)(mA + o0) + lane + 64 * j); wb[j] = __builtin_nontemporal_load((const u32x2*)(mA + o1) + lane + 64 * j); } }
        if (mB) {
#pragma unroll
            for (int j = 0; j < 4; ++j) { ya[j] = __builtin_nontemporal_load((const u32x2*)(mB + o0) + lane + 64 * j); yb[j] = __builtin_nontemporal_load((const u32x2*)(mB + o1) + lane + 64 * j); } }
        if (mA) {
            f32x4 ea[4], eb[4]; float sa = 0.f, sb = 0.f;
#pragma unroll
            for (int j = 0; j < 4; ++j) { ea[j] = RP_DEC(wa[j]); eb[j] = RP_DEC(wb[j]); sa += RP_SS(ea[j]); sb += RP_SS(eb[j]); }
            const float ra = 1.0f / sqrtf(wave_sum(sa) * (1.0f / D) + RMS_EPS), rb = 1.0f / sqrtf(wave_sum(sb) * (1.0f / D) + RMS_EPS);
#pragma unroll
            for (int j = 0; j < 4; ++j) { va[j] = va[j] + ea[j] * ra * ga[j]; vb[j] = vb[j] + eb[j] * rb * ga[j]; }
        }
        if (mB) {
            f32x4 ea[4], eb[4]; float sa = 0.f, sb = 0.f;
#pragma unroll
            for (int j = 0; j < 4; ++j) { ea[j] = RP_DEC(ya[j]); eb[j] = RP_DEC(yb[j]); sa += RP_SS(ea[j]); sb += RP_SS(eb[j]); }
            const float ra = 1.0f / sqrtf(wave_sum(sa) * (1.0f / D) + RMS_EPS), rb = 1.0f / sqrtf(wave_sum(sb) * (1.0f / D) + RMS_EPS);
#pragma unroll
            for (int j = 0; j < 4; ++j) { va[j] = va[j] + ea[j] * ra * gb[j]; vb[j] = vb[j] + eb[j] * rb * gb[j]; }
        }
        if (xout) {
#pragma unroll
            for (int j = 0; j < 4; ++j) { __builtin_nontemporal_store(va[j], (f32x4*)(xout + o0) + lane + 64 * j); __builtin_nontemporal_store(vb[j], (f32x4*)(xout + o1) + lane + 64 * j); } }
        if (xn) {
            float sa = 0.f, sb = 0.f;
#pragma unroll
            for (int j = 0; j < 4; ++j) { sa += RP_SS(va[j]); sb += RP_SS(vb[j]); }
            const float ra = 1.0f / sqrtf(wave_sum(sa) * (1.0f / D) + RMS_EPS), rb = 1.0f / sqrtf(wave_sum(sb) * (1.0f / D) + RMS_EPS);
#pragma unroll
            for (int j = 0; j < 4; ++j) { const f32x4 p = va[j] * ra * gq[j], q2 = vb[j] * rb * gq[j]; u32x2 w; w.x = cvtpk(p.x, p.y); w.y = cvtpk(p.z, p.w); ((u32x2*)(xn + o0) + lane)[64 * j] = w;
                w.x = cvtpk(q2.x, q2.y); w.y = cvtpk(q2.z, q2.w); ((u32x2*)(xn + o1) + lane)[64 * j] = w; }
        }
    }
    for (; row < M; row += ngw) {
        const size_t o0 = (size_t)row * D;
        f32x4 va[4];
#pragma unroll
        for (int j = 0; j < 4; ++j) va[j] = ((const f32x4*)(xin + o0) + lane)[64 * j];
        if (mA) { f32x4 ea[4]; float sa = 0.f;
#pragma unroll
            for (int j = 0; j < 4; ++j) { const u32x2 w = ((const u32x2*)(mA + o0) + lane)[64 * j]; ea[j] = RP_DEC(w); sa += RP_SS(ea[j]); }
            const float ra = 1.0f / sqrtf(wave_sum(sa) * (1.0f / D) + RMS_EPS);
#pragma unroll
            for (int j = 0; j < 4; ++j) va[j] = va[j] + ea[j] * ra * ga[j]; }
        if (mB) { f32x4 ea[4]; float sa = 0.f;
#pragma unroll
            for (int j = 0; j < 4; ++j) { const u32x2 w = ((const u32x2*)(mB + o0) + lane)[64 * j]; ea[j] = RP_DEC(w); sa += RP_SS(ea[j]); }
            const float ra = 1.0f / sqrtf(wave_sum(sa) * (1.0f / D) + RMS_EPS);
#pragma unroll
            for (int j = 0; j < 4; ++j) va[j] = va[j] + ea[j] * ra * gb[j]; }
        if (xout) {
#pragma unroll
            for (int j = 0; j < 4; ++j) ((f32x4*)(xout + o0) + lane)[64 * j] = va[j]; }
        if (xn) { float sa = 0.f;
#pragma unroll
            for (int j = 0; j < 4; ++j) sa += RP_SS(va[j]);
            const float ra = 1.0f / sqrtf(wave_sum(sa) * (1.0f / D) + RMS_EPS);
#pragma unroll
            for (int j = 0; j < 4; ++j) { const f32x4 p = va[j] * ra * gq[j]; u32x2 w; w.x = cvtpk(p.x, p.y); w.y = cvtpk(p.z, p.w); ((u32x2*)(xn + o0) + lane)[64 * j] = w; } }
    }
}
#undef RP_SS
#undef RP_DEC

__device__ __forceinline__ int pi32(int i) { return (i & 0x13) | ((i & 4) << 1) | ((i & 8) >> 1); }
#define MFMA32(a, b, c) __builtin_amdgcn_mfma_f32_32x32x16_bf16((a), (b), (c), 0, 0, 0)
constexpr int TILE_B = 16384, NBUF = 5, ATT_TAB_OFF = NBUF * TILE_B;
static_assert(ATT_TAB_OFF + 3 * 2 * 8 * 64 * 16 <= MISC_OFF, "attention LDS map");
struct TileLd { u32x4 k, v; };
__device__ __forceinline__ void tile_issue(TileLd& r, const bf16_t* Kg, const bf16_t* Vg, int tau) {
    r.k = *(const u32x4*)(Kg + (size_t)tau * 64 * D); r.v = *(const u32x4*)(Vg + tau * 64);
}
__device__ __forceinline__ void tile_commit(LAS unsigned char* ring, int buf, unsigned woff, const TileLd& r) {
    *(LAS u32x4*)(ring + buf * TILE_B + woff) = r.k; *(LAS u32x4*)(ring + buf * TILE_B + 8192 + woff) = r.v;
}
__device__ __forceinline__ void frag_k(bf16x8 (&kf)[2][4], const LAS unsigned char* tb, const unsigned (&fa)[4]) {
#pragma unroll
    for (int kvh = 0; kvh < 2; ++kvh)
#pragma unroll
        for (int d0 = 0; d0 < 4; ++d0) kf[kvh][d0] = *(const LAS bf16x8*)(tb + kvh * 4096 + fa[d0]);
}
__device__ __forceinline__ void frag_v(bf16x8 (&vf)[2][4], const LAS unsigned char* tb, const unsigned (&fa)[4]) {
#pragma unroll
    for (int db = 0; db < 2; ++db)
#pragma unroll
        for (int kb = 0; kb < 4; ++kb) vf[db][kb] = *(const LAS bf16x8*)(tb + 8192 + db * 4096 + fa[kb]);
}
template <int B0> __device__ __forceinline__ bf16x8 pack8(const f32x16& p) {
    u32x4 w; w.x = cvtpk(p[B0], p[B0 + 1]); w.y = cvtpk(p[B0 + 2], p[B0 + 3]); w.z = cvtpk(p[B0 + 4], p[B0 + 5]); w.w = cvtpk(p[B0 + 6], p[B0 + 7]);
    return __builtin_bit_cast(bf16x8, w);
}
__device__ __forceinline__ void qk_tile(f32x16& p0, f32x16& p1, const bf16x8 (&kf)[2][4], const bf16x8 (&qr)[4]) {
#pragma unroll
    for (int d0 = 0; d0 < 4; ++d0) { p0 = MFMA32(kf[0][d0], qr[d0], p0); p1 = MFMA32(kf[1][d0], qr[d0], p1); }
}
__device__ __forceinline__ void pv_tile(f32x16& o0, f32x16& o1, const bf16x8 (&vf)[2][4], const f32x16& p0, const f32x16& p1) {
    const bf16x8 pw0 = pack8<0>(p0), pw1 = pack8<8>(p0), pw2 = pack8<0>(p1), pw3 = pack8<8>(p1);
    o0 = MFMA32(vf[0][0], pw0, o0); o1 = MFMA32(vf[1][0], pw0, o1);
    o0 = MFMA32(vf[0][1], pw1, o0); o1 = MFMA32(vf[1][1], pw1, o1);
    o0 = MFMA32(vf[0][2], pw2, o0); o1 = MFMA32(vf[1][2], pw2, o1);
    o0 = MFMA32(vf[0][3], pw3, o0); o1 = MFMA32(vf[1][3], pw3, o1);
}
__device__ __forceinline__ void store_o(bf16_t* Op, const f32x16& o0, const f32x16& o1, float sc) {
    const f32x16 a = o0 * sc, b = o1 * sc;
    *(bf16x8*)(Op + 0) = pack8<0>(a); *(bf16x8*)(Op + 16) = pack8<8>(a); *(bf16x8*)(Op + 32) = pack8<0>(b); *(bf16x8*)(Op + 48) = pack8<8>(b);
}
__device__ __forceinline__ void gload16(u32x4& dst, const void* p) { asm volatile("global_load_dwordx4 %0, %1, off" : "=&v"(dst) : "v"(p) : "memory"); }
constexpr int N_ITEMS = BATCH * H * 8;

__device__ __forceinline__ void item_decode(int it, int& bh, int& grp) {
    if (gridDim.x == 256) { const int i = it >> 8, x = blockIdx.x & 7, m = blockIdx.x >> 3, qq = m >> 3; bh = (8 * (qq >> 1) + i) * H + 2 * x + (qq & 1); grp = ((m & 7) + i) & 7; }
    else { bh = it >> 3; grp = ((it & 7) + (it >> 8)) & 7; }
}
__device__ __forceinline__ void attn0_phase(LAS unsigned char* lds, const bf16_t* Q, const bf16_t* K, const bf16_t* Vt, bf16_t* O, const float* relb, int tid, int lane, int wave) {
    asm volatile("" : "+v"(tid), "+v"(lane));
    LAS f32x4* tab = (LAS f32x4*)(lds + ATT_TAB_OFF);
    const int q = lane & 31, hi = lane >> 5, j = wave >> 1, hf = wave & 1;
    const int R = tid >> 3, cc = tid & 7, wslot = (R & 32) | pi32(R & 31);
    const unsigned woff = (unsigned)(wslot * 128 + ((cc ^ ((wslot >> 1) & 7)) << 4));
    unsigned fa[4];
#pragma unroll
    for (int t = 0; t < 4; ++t) fa[t] = (unsigned)(q * 128 + (((2 * t + hi) ^ ((q >> 1) & 7)) << 4));
    int cur_h = -1; float cfar = 0.f;
    for (int it = blockIdx.x; it < N_ITEMS; it += gridDim.x) {
        int bh, grp; item_decode(it, bh, grp);
        const int c0 = grp * 4, b = bh / H, h = bh % H, c = c0 + j;
        if (h != cur_h) {
            for (int e = tid; e < 3 * 2 * 8 * 64; e += 512) {
                const int ln = e & 63, g = (e >> 6) & 7, ehf = (e >> 9) & 1, dl = e >> 10;
                const int qi = 32 * ehf + (ln & 31), lhi = ln >> 5;
                f32x4 v;
#pragma unroll
                for (int t = 0; t < 4; ++t) { const int rr = 4 * g + t, pp = rr >> 4, r = rr & 15, kvi = 32 * pp + 16 * (r >> 3) + 8 * lhi + (r & 7);
                    int rel = 64 * dl + qi - kvi; rel = rel < -63 ? -63 : (rel > 128 ? 128 : rel); v[t] = relb[h * NREL + rel + 63] * LOG2E; }
                tab[e] = v;
            }
            cfar = relb[h * NREL + NREL - 1] * LOG2E; cur_h = h;
        }
        const bf16_t* Kg = K + (size_t)(b * SEQ + R) * D + h * HD + cc * 8;
        const bf16_t* Vg = Vt + (size_t)(h * HD + R) * M + (size_t)b * SEQ + cc * 8;
        const int q0 = c * 64 + hf * 32;
        const bf16_t* Qp = Q + (size_t)(b * SEQ + q0 + q) * D + h * HD + hi * 8;
        bf16x8 qr[4];
#pragma unroll
        for (int d0 = 0; d0 < 4; ++d0) qr[d0] = __builtin_nontemporal_load((const bf16x8*)(Qp + d0 * 16));
        {
            TileLd pl[4];
#pragma unroll
            for (int k = 0; k < 4; ++k) { const int tau = c0 - 8 + k; tile_issue(pl[k], Kg, Vg, tau < 0 ? 0 : tau); }
#pragma unroll
            for (int k = 0; k < 4; ++k) { const int tau = c0 - 8 + k; tile_commit(lds, (tau + 15) % NBUF, woff, pl[k]); }
        }
        float m_run = -INFINITY, l_run = 0.f; f32x16 o0 = {}, o1 = {};
        u32x4 rka, rva, rkb, rvb;
        { const int t0 = c0 - 4 < 0 ? 0 : c0 - 4; gload16(rka, Kg + (size_t)t0 * 64 * D); gload16(rva, Vg + t0 * 64); }
        __syncthreads();
#define A0_STEP(S, CK, CV, NK, NV, LOADNEXT) do { \
            const int pre = c0 - 4 + (S); const bool do_pre = ((S) < 8) && (pre >= 0); \
            if (LOADNEXT) { int t1 = pre + 1; t1 = t1 < 0 ? 0 : (t1 > c0 + 3 ? c0 + 3 : t1); gload16(NK, Kg + (size_t)t1 * 64 * D); gload16(NV, Vg + t1 * 64); }     \
            const int tau = c - 8 + (S); \
            if (MK_SKEW0 && wave >= 4) __builtin_amdgcn_s_sleep(MK_SKEW0); \
            if (tau >= 0) { \
                const LAS unsigned char* tb = lds + ((tau + 15) % NBUF) * TILE_B; \
                const int dl = 8 - (S); \
                bf16x8 kf[2][4], vf[2][4]; \
                frag_k(kf, tb, fa); \
                f32x16 p0 = {}, p1 = {}; \
                float cb = cfar; \
                if (dl <= 2) { const LAS f32x4* tp = tab + ((dl * 2 + hf) * 8) * 64 + lane; cb = 0.f; \
                    _Pragma("unroll") for (int g = 0; g < 4; ++g) { const f32x4 a = tp[g * 64], bb = tp[(g + 4) * 64]; \
                        _Pragma("unroll") for (int t = 0; t < 4; ++t) { p0[4 * g + t] = a[t]; p1[4 * g + t] = bb[t]; } } \
                } \
                qk_tile(p0, p1, kf, qr); \
                frag_v(vf, tb, fa); \
                float mx = fmaxf(p0[0], p1[0]); \
                _Pragma("unroll") for (int r = 1; r < 16; ++r) mx = fmaxf(mx, fmaxf(p0[r], p1[r])); \
                mx = fmaxf(mx, __shfl_xor(mx, 32)) + cb; \
                if (__any(mx > m_run)) { \
                    const float mn = fmaxf(m_run, mx), f = ex2(m_run - mn); m_run = mn; \
                    l_run *= f; o0 = o0 * f; o1 = o1 * f; \
                } \
                const float ms = m_run - cb; \
                float sm = 0.f; \
                _Pragma("unroll") for (int r = 0; r < 16; ++r) { p0[r] = ex2(p0[r] - ms); p1[r] = ex2(p1[r] - ms); sm += p0[r] + p1[r]; } \
                l_run += sm; \
                pv_tile(o0, o1, vf, p0, p1); \
            } \
            if (LOADNEXT) asm volatile("s_waitcnt vmcnt(2)" : "+v"(CK), "+v"(CV) :: "memory");     \
            else asm volatile("s_waitcnt vmcnt(0)" : "+v"(CK), "+v"(CV) :: "memory"); \
            if (do_pre) { *(LAS u32x4*)(lds + ((pre + 15) % NBUF) * TILE_B + woff) = CK; *(LAS u32x4*)(lds + ((pre + 15) % NBUF) * TILE_B + 8192 + woff) = CV; } \
            __syncthreads(); \
        } while (0)
#pragma unroll 1
        for (int s = 0; s < 6; s += 2) { A0_STEP(s, rka, rva, rkb, rvb, 1); A0_STEP(s + 1, rkb, rvb, rka, rva, 1); }
        A0_STEP(6, rka, rva, rkb, rvb, 1);
        A0_STEP(7, rkb, rvb, rka, rva, 0);
        A0_STEP(8, rka, rva, rkb, rvb, 0);
#undef A0_STEP
        const float l = l_run + __shfl_xor(l_run, 32);
        store_o(O + (size_t)(b * SEQ + q0 + q) * D + h * HD + hi * 8, o0, o1, 1.0f / l);
    }
}

__device__ __forceinline__ void attn1_phase(LAS unsigned char* lds, const bf16_t* Q, const bf16_t* K, const bf16_t* Vt, bf16_t* O, int tid, int lane, int wave) {
    asm volatile("" : "+v"(tid), "+v"(lane));
    const int q = lane & 31, hi = lane >> 5, j = wave >> 1, hf = wave & 1;
    const int R = tid >> 3, cc = tid & 7, wslot = (R & 32) | pi32(R & 31);
    const unsigned woff = (unsigned)(wslot * 128 + ((cc ^ ((wslot >> 1) & 7)) << 4));
    unsigned fa[4];
#pragma unroll
    for (int t = 0; t < 4; ++t) fa[t] = (unsigned)(q * 128 + (((2 * t + hi) ^ ((q >> 1) & 7)) << 4));
    const int trel = 32 * hf + q;
    for (int it = blockIdx.x; it < N_ITEMS; it += gridDim.x) {
        int bh, grp; item_decode(it, bh, grp);
        const int c0 = grp * 4, b = bh / H, h = bh % H, T = c0 + j;
        const bf16_t* Kg = K + (size_t)(b * SEQ + R) * D + h * HD + cc * 8;
        const bf16_t* Vg = Vt + (size_t)(h * HD + R) * M + (size_t)b * SEQ + cc * 8;
        const int q0 = T * 64 + hf * 32;
        const bf16_t* Qp = Q + (size_t)(b * SEQ + q0 + q) * D + h * HD + hi * 8;
        bf16x8 qr[4];
#pragma unroll
        for (int d0 = 0; d0 < 4; ++d0) qr[d0] = __builtin_nontemporal_load((const bf16x8*)(Qp + d0 * 16));
        {
            TileLd pl[4];
#pragma unroll
            for (int k = 0; k < 4; ++k) tile_issue(pl[k], Kg, Vg, c0 + k);
#pragma unroll
            for (int k = 0; k < 4; ++k) tile_commit(lds, (c0 + k) % NBUF, woff, pl[k]);
        }
        float carry = 1.0f; f32x16 o0 = {}, o1 = {}; bool done = false;
        u32x4 rka, rva, rkb, rvb;
        { const int t0 = c0 - 1 < 0 ? 0 : c0 - 1; gload16(rka, Kg + (size_t)t0 * 64 * D); gload16(rva, Vg + t0 * 64); }
        __syncthreads();
        bool more = true;
#define A1_STEP(S, CK, CV, NK, NV) do { \
            const int pre = c0 - (S) - 1; const bool do_pre = pre >= 0; \
            { const int t1 = pre - 1 < 0 ? 0 : pre - 1; gload16(NK, Kg + (size_t)t1 * 64 * D); gload16(NV, Vg + t1 * 64); } \
            const int tau = T - (S); \
            if (MK_SKEW1 && wave >= 4) __builtin_amdgcn_s_sleep(MK_SKEW1); \
            if (!done) { \
                const LAS unsigned char* tb = lds + (tau % NBUF) * TILE_B; \
                bf16x8 kf[2][4], vf[2][4]; \
                frag_k(kf, tb, fa); \
                f32x16 p0 = {}, p1 = {}; \
                qk_tile(p0, p1, kf, qr); \
                frag_v(vf, tb, fa); \
                const bool diag = ((S) == 0); \
                f32x16 r0, r1; \
                _Pragma("unroll") for (int r = 0; r < 16; ++r) { \
                    const int kvr = 16 * (r >> 3) + 8 * hi + (r & 7); \
                    { const float e = ex2(fminf(p0[r], 64.f)), rc = __builtin_amdgcn_rcpf(1.0f + e); const bool ok = !diag || (kvr < trel); r0[r] = ok ? rc : 1.0f; p0[r] = ok ? e * rc : 0.f; } \
                    { const float e = ex2(fminf(p1[r], 64.f)), rc = __builtin_amdgcn_rcpf(1.0f + e); const bool ok = !diag || (kvr + 32 < trel); r1[r] = ok ? rc : 1.0f; p1[r] = ok ? e * rc : 0.f; } \
                } \
                float Rn[4], Pn[4]; \
                Rn[0] = ((r0[0] * r0[1]) * (r0[2] * r0[3])) * ((r0[4] * r0[5]) * (r0[6] * r0[7])); \
                Rn[1] = ((r0[8] * r0[9]) * (r0[10] * r0[11])) * ((r0[12] * r0[13]) * (r0[14] * r0[15])); \
                Rn[2] = ((r1[0] * r1[1]) * (r1[2] * r1[3])) * ((r1[4] * r1[5]) * (r1[6] * r1[7])); \
                Rn[3] = ((r1[8] * r1[9]) * (r1[10] * r1[11])) * ((r1[12] * r1[13]) * (r1[14] * r1[15])); \
                _Pragma("unroll") for (int a = 0; a < 4; ++a) Pn[a] = __shfl_xor(Rn[a], 32); \
                float tail[4]; float after = carry; \
                _Pragma("unroll") for (int a = 3; a >= 0; --a) { tail[a] = after * (hi == 0 ? Pn[a] : 1.0f); after *= Rn[a] * Pn[a]; } \
                _Pragma("unroll") for (int a = 0; a < 2; ++a) { float s0 = tail[a], s1 = tail[a + 2]; \
                    _Pragma("unroll") for (int jj = 7; jj >= 0; --jj) { const int r = 8 * a + jj; p0[r] *= s0; s0 *= r0[r]; p1[r] *= s1; s1 *= r1[r]; } } \
                carry = after; \
                pv_tile(o0, o1, vf, p0, p1); \
                if (tau == 0 || __all(carry < 1e-37f)) done = true; \
            } \
            asm volatile("s_waitcnt vmcnt(2)" : "+v"(CK), "+v"(CV) :: "memory");     \
            if (do_pre) { *(LAS u32x4*)(lds + (pre % NBUF) * TILE_B + woff) = CK; *(LAS u32x4*)(lds + (pre % NBUF) * TILE_B + 8192 + woff) = CV; } \
            { LAS unsigned* vs_ = (LAS unsigned*)(lds + MISC_OFF + 32) + ((S) % 3) * 8;     \
              if (lane == 0) vs_[wave] = done ? 0u : 1u; \
              __syncthreads(); \
              const u32x4 f0_ = *(LAS u32x4*)vs_, f1_ = *(LAS u32x4*)(vs_ + 4); \
              more = ((f0_.x | f0_.y) | (f0_.z | f0_.w) | (f1_.x | f1_.y) | (f1_.z | f1_.w)) != 0u; } \
        } while (0)
#pragma unroll 1
        for (int s = 0; more; s += 2) { A1_STEP(s, rka, rva, rkb, rvb); if (!more) break; A1_STEP(s + 1, rkb, rvb, rka, rva); }
#undef A1_STEP
        asm volatile("s_waitcnt vmcnt(0)" ::: "memory");
        asm volatile("" :: "v"(rka), "v"(rva), "v"(rkb), "v"(rvb));
        store_o(O + (size_t)(b * SEQ + q0 + q) * D + h * HD + hi * 8, o0, o1, 1.0f);
    }
}

struct Args { const float* x; const float* g_pre_mix; const float* g_post_mix; const float* w_qkv; const float* w_o; const float* rel_bias;
              const float* g_pre_ffn; const float* g_post_ffn; const float* w_gate; const float* w_up; const float* w_down; float* out; unsigned char* ws; int ph_lo, ph_hi; };

__global__ void __launch_bounds__(512, 2) mega_fwd(Args a) {
    extern __shared__ __attribute__((aligned(16))) unsigned char lds_raw[];
    LAS unsigned char* lds = (LAS unsigned char*)lds_raw;
    const int tid = threadIdx.x, lane = tid & 63, wave = __builtin_amdgcn_readfirstlane(tid >> 6);
    const int G = gridDim.x, gw = blockIdx.x * 8 + wave, ngw = G * 8;
    unsigned char* ws = a.ws;
    bf16_t* XN = (bf16_t*)(ws + WS_XN); bf16_t* Qb = (bf16_t*)(ws + WS_Q); bf16_t* Kb = (bf16_t*)(ws + WS_K); bf16_t* Vt = (bf16_t*)(ws + WS_VT);
    bf16_t* Ob = (bf16_t*)(ws + WS_O); bf16_t* Mb = (bf16_t*)(ws + WS_MB); bf16_t* Hb = (bf16_t*)(ws + WS_H);
    bf16_t* Mb2 = Ob;

    const int lo = a.ph_lo, hi = a.ph_hi;
    volatile LAS unsigned* MISC = (volatile LAS unsigned*)(lds + MISC_OFF);
    unsigned* barw = (unsigned*)(ws + WS_CTL);
    if (tid < 2) MISC[tid] = 0u;
    __syncthreads();
    if (hi > NPH) cg::this_grid().sync();
    XcdBarrier bar = xcd_barrier_post(barw, MISC);
#define RUN(p) (lo <= (p) && (p) < hi)
#define SEAM(p) do { if (lo <= (p) && (p) + 1 < hi) xcd_barrier(bar); } while (0)
#define REP(bit) for (int rep_ = 0; rep_ < ((MK_DUP & (bit)) ? 2 : 1); ++rep_, ((MK_DUP & (bit)) && rep_ < 2 ? xcd_barrier(bar) : (void)0))
    if (RUN(0)) REP(64) {
        LAS float* scr = (LAS float*)(lds + wave * 16384);
        constexpr int I_QKV = (D / 64) * (3 * D / 32), I_O = (D / 64) * (D / 32), I_G = (D / 64) * (FF / 32), I_D = (FF / 64) * (D / 32);
        constexpr int I_LAYER = I_QKV + I_O + 2 * I_G + I_D;
        for (int it = gw; it < DEPTH * I_LAYER; it += ngw) {
            const int l = it / I_LAYER; int r = it % I_LAYER;
            unsigned char* wl = ws + (size_t)l * W_LAYER;
            if (r < I_QKV) { const int nblk = 3 * D / 32, kb = r / nblk, nb = r % nblk; transpose_item(a.w_qkv + (size_t)l * D * 3 * D, D, 3 * D, (bf16_t*)(wl + W_QKV), 64 * kb, 32 * nb, 32 * nb, scr, lane); continue; } r -= I_QKV;
            if (r < I_O) { const int nblk = D / 32, kb = r / nblk, nb = r % nblk; transpose_item(a.w_o + (size_t)l * D * D, D, D, (bf16_t*)(wl + W_O), 64 * kb, 32 * nb, 32 * nb, scr, lane); continue; } r -= I_O;
            if (r < 2 * I_G) { const int up = r >= I_G; if (up) r -= I_G; const int nblk = FF / 32, kb = r / nblk, nb = r % nblk, n0 = 32 * nb;
                transpose_item((up ? a.w_up : a.w_gate) + (size_t)l * D * FF, D, FF, (bf16_t*)(wl + W_13), 64 * kb, n0, 256 * (n0 >> 7) + (n0 & 127) + (up ? 128 : 0), scr, lane); continue; } r -= 2 * I_G;
            { const int nblk = D / 32, kb = r / nblk, nb = r % nblk; transpose_item(a.w_down + (size_t)l * FF * D, FF, D, (bf16_t*)(wl + W_2), 64 * kb, 32 * nb, 32 * nb, scr, lane); }
        }
        row_phase(a.x, nullptr, nullptr, nullptr, nullptr, nullptr, XN, a.g_pre_mix, gw, ngw, lane);
    }
    SEAM(0);
    for (int l = 0; l < DEPTH; ++l) {
        const int pb = 1 + 7 * l;
        unsigned char* wl = ws + (size_t)l * W_LAYER;
        if (RUN(pb + 0)) REP(1) {
            { pg8::Gemm g{XN, (const bf16_t*)(wl + W_QKV), M, 2 * D, D}; pg8::StaticOrder S; S.init(M, 2 * D, G, (int)blockIdx.x);
              pg8::EpiBf16<0> E{Qb, D, nullptr, D, (size_t)(WS_K - WS_Q) / 2, C2};
              pg8::gemm_phase<pg8::EpiBf16<0>, pg8::StaticOrder, true, true>(lds, g, S, E); }
            { pg8::Gemm g{(const bf16_t*)(wl + W_QKV) + (size_t)2 * D * D, XN, D, M, D}; pg8::StaticOrder S; S.init(D, M, G, (int)blockIdx.x);
              pg8::EpiBf16<0> E{Vt, M, nullptr, 0, 0, 1.f};
              pg8::gemm_phase<pg8::EpiBf16<0>, pg8::StaticOrder, true, true>(lds, g, S, E); }
        }
        SEAM(pb + 0);
        if (RUN(pb + 1)) REP((l & 1) ? 4 : 2) {
            if ((l & 1) == 0) attn0_phase(lds, Qb, Kb, Vt, Ob, a.rel_bias + (size_t)(l >> 1) * H * NREL, tid, lane, wave);
            else attn1_phase(lds, Qb, Kb, Vt, Ob, tid, lane, wave);
        }
        SEAM(pb + 1);
        if (RUN(pb + 2)) REP(8) {
            pg8::Gemm g{Ob, (const bf16_t*)(wl + W_O), M, D, D}; pg8::StaticOrder S; S.init(M, D, G, (int)blockIdx.x);
            pg8::EpiBf16<0> E{Mb, D, nullptr, 0, 0, 1.f};
            pg8::gemm_phase<pg8::EpiBf16<0>, pg8::StaticOrder, true, true>(lds, g, S, E);
        }
        SEAM(pb + 2);
        if (RUN(pb + 3))
            row_phase(l == 0 ? a.x : a.out, Mb, a.g_post_mix + (size_t)l * D, nullptr, nullptr, nullptr, XN, a.g_pre_ffn + (size_t)l * D, gw, ngw, lane);
        SEAM(pb + 3);
        if (RUN(pb + 4)) REP(16) {
            pg8::Gemm g{XN, (const bf16_t*)(wl + W_13), M, 2 * FF, D}; GuOrder S; S.init(M, 2 * FF, G, (int)blockIdx.x);
            EpiSwiGLU E{Hb, FF};
            pg8::gemm_phase<EpiSwiGLU, GuOrder, true, true>(lds, g, S, E);
        }
        SEAM(pb + 4);
        if (RUN(pb + 5)) REP(32) {
            pg8::Gemm g{Hb, (const bf16_t*)(wl + W_2), M, D, FF}; pg8::StaticOrder S; S.init(M, D, G, (int)blockIdx.x);
            pg8::EpiBf16<0> E{Mb2, D, nullptr, 0, 0, 1.f};
            pg8::gemm_phase<pg8::EpiBf16<0>, pg8::StaticOrder, true, true>(lds, g, S, E);
        }
        SEAM(pb + 5);
        if (RUN(pb + 6)) {
            const bool last = (l == DEPTH - 1);
            row_phase(l == 0 ? a.x : a.out, Mb, a.g_post_mix + (size_t)l * D, Mb2, a.g_post_ffn + (size_t)l * D, a.out, last ? nullptr : XN, last ? nullptr : a.g_pre_mix + (size_t)(l + 1) * D, gw, ngw, lane);
        }
        SEAM(pb + 6);
    }
#undef RUN
#undef SEAM
#undef REP
}

extern "C" void kernel_launch(void* const* d_in, const int* in_sizes, int n_in, void* d_out, int out_size, void* d_ws, size_t ws_size, hipStream_t stream) {
    static int grid = 0;
    if (grid == 0) {
        if (n_in != 11 || in_sizes[0] != M * D || out_size != M * D || ws_size < WS_END) { fprintf(stderr, "kernel_launch: unexpected shapes (n_in %d, in0 %d, out %d, ws %zu); nothing launched\n", n_in, n_in > 0 ? in_sizes[0] : -1, out_size, ws_size); grid = -1; return; }
        int dev = 0, cus = 0, per_cu = 0;
        if (hipGetDevice(&dev) != hipSuccess || hipDeviceGetAttribute(&cus, hipDeviceAttributeMultiprocessorCount, dev) != hipSuccess) { grid = -1; return; }
        if (hipFuncSetAttribute((const void*)mega_fwd, hipFuncAttributeMaxDynamicSharedMemorySize, LDS_BYTES) != hipSuccess) { fprintf(stderr, "kernel_launch: hipFuncSetAttribute failed\n"); grid = -1; return; }
        if (hipOccupancyMaxActiveBlocksPerMultiprocessor(&per_cu, (const void*)mega_fwd, 512, LDS_BYTES) != hipSuccess || per_cu < 1) { fprintf(stderr, "kernel_launch: occupancy query says %d\n", per_cu); per_cu = 1; }
        (void)hipGetLastError();
        grid = cus * per_cu;
    }
    if (grid < 0) return;
    Args a{};
    a.x = (const float*)d_in[0]; a.g_pre_mix = (const float*)d_in[1]; a.g_post_mix = (const float*)d_in[2]; a.w_qkv = (const float*)d_in[3]; a.w_o = (const float*)d_in[4]; a.rel_bias = (const float*)d_in[5];
    a.g_pre_ffn = (const float*)d_in[6]; a.g_post_ffn = (const float*)d_in[7]; a.w_gate = (const float*)d_in[8]; a.w_up = (const float*)d_in[9]; a.w_down = (const float*)d_in[10];
    a.out = (float*)d_out; a.ws = (unsigned char*)d_ws;
#if MK_MULTI
    for (int ph = 0; ph < NPH; ++ph) { a.ph_lo = ph; a.ph_hi = ph + 1; hipLaunchKernelGGL(mega_fwd, dim3(grid), dim3(512), LDS_BYTES, stream, a); }
#else
    a.ph_lo = 0; a.ph_hi = NPH;
    if (hipMemsetAsync((char*)d_ws + WS_CTL, 0, 16384, stream) != hipSuccess) { fprintf(stderr, "kernel_launch: hipMemsetAsync failed\n"); return; }
    void* args[] = {&a};
    const hipError_t e = hipLaunchCooperativeKernel((const void*)mega_fwd, dim3(grid), dim3(512), args, LDS_BYTES, stream);
    if (e != hipSuccess) fprintf(stderr, "kernel_launch: cooperative launch failed: %s (grid %d)\n", hipGetErrorString(e), grid);
#endif
}
```

```cpp
#include <hip/hip_runtime.h>
#include <hip/hip_cooperative_groups.h>
#include <cstdio>
#include <cstdint>
namespace cg = cooperative_groups;
#define LAS __attribute__((address_space(3)))
namespace pg8 {
#define PG8_LAS __attribute__((address_space(3)))
typedef unsigned short bf16_t;
typedef short bf16x8 __attribute__((ext_vector_type(8)));
typedef float f32x4 __attribute__((ext_vector_type(4)));
typedef unsigned u32x4 __attribute__((ext_vector_type(4)));
constexpr int BM = 256, BK = 64, HALF = 128, HTB = HALF * BK * 2  , STAGE_BYTES = 8 * HTB, NXCD = 8, WGM = 4;

__host__ __device__ __forceinline__ int lds_byte(int r, int c) { const int st = (r >> 4) * 2 + (c >> 5), rr = r & 15, cc = c & 31, ob = rr * 64 + cc * 2; return st * 1024 + (ob ^ (((ob >> 9) & 1) << 5)); }
__host__ __device__ __forceinline__ void stage_rc(int b, int& R, int& C) { const int st = b / 1024, sb = b % 1024, swz = sb ^ (((sb >> 9) & 1) << 5); R = (st >> 1) * 16 + swz / 64; C = (st & 1) * 32 + (swz % 64) / 2; }
__host__ __device__ __forceinline__ int perm32(int rho) { const int n = rho >> 4, i = rho & 15; return 8 * (i >> 2) + 4 * n + (i & 3); }

struct Unit { int pm, pn; };
struct Gemm { const bf16_t* A; const bf16_t* Bt; int M, N, K; };

struct StaticOrder {
    int nM, nN, nwg, G, c;
    __host__ __device__ void init(int M, int N, int G_, int c_) { nM = M / BM; nN = N / BM; nwg = nM * nN; G = G_; c = c_; }
    __host__ __device__ bool next(int i, Unit& u) const {
        const long L = (long)i * G + c; if (L >= nwg) return false;
        int wgid = (int)L; { const int q = nwg / NXCD, r = nwg % NXCD, xcd = wgid % NXCD, off = wgid / NXCD; wgid = (xcd < r ? xcd * (q + 1) : r * (q + 1) + (xcd - r) * q) + off; }
        const int nig = WGM * nN, gid = wgid / nig, fm = gid * WGM, gsz = (nM - fm) < WGM ? (nM - fm) : WGM;
        u.pm = fm + ((wgid % nig) % gsz); u.pn = (wgid % nig) / gsz;
        if (nM == 128) u.pm = (u.pm & 15) * 8 + (u.pm >> 4);
        if (nN == 128) u.pn = (u.pn & 15) * 8 + (u.pn >> 4);
        return true;
    }
    __device__ __forceinline__ void a_ready(const Unit&) const {}
    __device__ __forceinline__ void done(const Unit&) const {}
};

__device__ __forceinline__ unsigned cvt_pk_bf16(float lo, float hi) { unsigned r; asm volatile("v_cvt_pk_bf16_f32 %0, %1, %2" : "=v"(r) : "v"(lo), "v"(hi)); return r; }
typedef float f32x2 __attribute__((ext_vector_type(2)));
__device__ __forceinline__ f32x2 gelu_pk(f32x2 v) {
    const f32x2 av = __builtin_elementwise_abs(v), d = av * 0.2316418882f + 1.0f;
    f32x2 t; t.x = __builtin_amdgcn_rcpf(d.x); t.y = __builtin_amdgcn_rcpf(d.y);
    f32x2 q = t * 0.5307027145f + (-0.7265760135f); q = q * t + 0.7107068705f; q = q * t + (-0.142248368f); q = q * t + 0.127414796f; q = q * t;
    const f32x2 s = (v * v) * (-0.72134752044f);
    f32x2 e; e.x = __builtin_amdgcn_exp2f(s.x); e.y = __builtin_amdgcn_exp2f(s.y);
    const f32x2 m = v * (q * e), r = v - m;
    f32x2 o; o.x = v.x < 0.f ? m.x : r.x; o.y = v.y < 0.f ? m.y : r.y; return o;
}

template <int ACT  > struct EpiBf16 {
    static constexpr bool PERM = true, AFTER_DRAIN = false; static_assert(ACT == 0 || ACT == 1, "EpiBf16: ACT is 0 (none) or 1 (gelu_pk)");
    bf16_t* O; int ldc; const float* bias; int split_cols; size_t split_stride; float scale0;
    __device__ __forceinline__ void operator()(const f32x4 (&acc)[2][2][4][2], const Unit& u, int wr, int wc, int fr, int fq) const {
        const int row0 = u.pm * BM + wr * 64 + fr; int colt = u.pn * BM; bf16_t* base = O;
        float sc = 1.f; if (split_cols) { const int t = colt / split_cols; base += (size_t)t * split_stride; colt -= t * split_cols; if (t == 0) sc = scale0; }
        const int col0 = colt + wc * 32 + 8 * fq, bcol0 = u.pn * BM + wc * 32 + 8 * fq;
        f32x4 bv[2][2];
#pragma unroll
        for (int bj = 0; bj < 2; ++bj)
#pragma unroll
            for (int n = 0; n < 2; ++n) bv[bj][n] = bias ? *(const f32x4*)(bias + bcol0 + bj * HALF + 4 * n) : (f32x4){0.f, 0.f, 0.f, 0.f};
#pragma unroll
        for (int ai = 0; ai < 2; ++ai)
#pragma unroll
            for (int m = 0; m < 4; ++m) { bf16_t* rowp = base + (size_t)(row0 + ai * HALF + m * 16) * ldc + col0;
#pragma unroll
                for (int bj = 0; bj < 2; ++bj) { f32x4 v0 = acc[ai][bj][m][0] + bv[bj][0], v1 = acc[ai][bj][m][1] + bv[bj][1];
                    if (ACT == 1) { f32x2 a = gelu_pk((f32x2){v0[0], v0[1]}), b = gelu_pk((f32x2){v0[2], v0[3]}), c = gelu_pk((f32x2){v1[0], v1[1]}), d = gelu_pk((f32x2){v1[2], v1[3]});
                        v0 = (f32x4){a.x, a.y, b.x, b.y}; v1 = (f32x4){c.x, c.y, d.x, d.y}; }
                    v0 = v0 * sc; v1 = v1 * sc; u32x4 w; w.x = cvt_pk_bf16(v0[0], v0[1]); w.y = cvt_pk_bf16(v0[2], v0[3]); w.z = cvt_pk_bf16(v1[0], v1[1]); w.w = cvt_pk_bf16(v1[2], v1[3]);
                    *(u32x4*)(rowp + bj * HALF) = w; } }
    }
};
template <class Epi, class Sched, bool ALIGN_EPI = false, bool SP2 = false>
__device__ __forceinline__ void gemm_phase(PG8_LAS unsigned char* lds, const Gemm g, const Sched& S, const Epi& E) {
    int tid_ = threadIdx.x; asm volatile("" : "+v"(tid_));
    const int tid = tid_, wid = __builtin_amdgcn_readfirstlane(tid >> 6), lane = tid & 63, wr = wid >> 2, wc = wid & 3, fr = lane & 15, fq = lane >> 4;
    const int K = g.K, nt = K / BK;
    unsigned voffA[2], voffB[2];
#pragma unroll
    for (int i = 0; i < 2; ++i) { int R, C; stage_rc(tid * 16 + i * 8192, R, C); const int Rb = Epi::PERM ? ((R & ~31) + perm32(R & 31)) : R;
        voffA[i] = (unsigned)(R * K + C) * 2u; voffB[i] = (unsigned)(Rb * K + C) * 2u; }
    const size_t kstep = (size_t)(BK * 2);
    const size_t hstep = (size_t)HALF * K * 2;
    const size_t tstep = 2 * hstep;
    const unsigned ldsw = (unsigned)wid * 1024u;
    const int aoff = lds_byte(wr * 64 + fr, fq * 8), boff = lds_byte(wc * 32 + fr, fq * 8);
#define PG8_SA(b, h) (((b) * 2 + (h)) * HTB)
#define PG8_SB(b, h) ((4 + (b) * 2 + (h)) * HTB)
#define PG8_STAGE(bufoff, gbase, voff) do { _Pragma("unroll") for (int _i = 0; _i < 2; ++_i) \
        __builtin_amdgcn_global_load_lds((const unsigned*)((const char*)(gbase) + (voff)[_i]), (PG8_LAS unsigned*)(lds + (bufoff) + ldsw + _i * 8192), 16, 0, 0); } while (0)
#define PG8_LDA(dst, b, h) do { _Pragma("unroll") for (int m = 0; m < 4; ++m) _Pragma("unroll") for (int k = 0; k < 2; ++k) dst[m][k] = *(const PG8_LAS bf16x8*)(lds + PG8_SA(b, h) + aoff + m * 2048 + k * 1024); } while (0)
#define PG8_LDB(dst, b, h) do { _Pragma("unroll") for (int n = 0; n < 2; ++n) _Pragma("unroll") for (int k = 0; k < 2; ++k) dst[n][k] = *(const PG8_LAS bf16x8*)(lds + PG8_SB(b, h) + boff + n * 2048 + k * 1024); } while (0)
#define PG8_MMA(ai, bj, At, Bt) do { __builtin_amdgcn_s_setprio(1); _Pragma("unroll") for (int m = 0; m < 4; ++m) _Pragma("unroll") for (int n = 0; n < 2; ++n) _Pragma("unroll") for (int k = 0; k < 2; ++k) \
        acc[ai][bj][m][n] = __builtin_amdgcn_mfma_f32_16x16x32_bf16(Bt[n][k], At[m][k], acc[ai][bj][m][n], 0, 0, 0); __builtin_amdgcn_s_setprio(0); } while (0)
#define PG8_WAIT_V(n) asm volatile("s_waitcnt vmcnt(" #n ")" ::: "memory")
#define PG8_WAIT_L(n) asm volatile("s_waitcnt lgkmcnt(" #n ")" ::: "memory")
#define PG8_BAR __builtin_amdgcn_s_barrier()
#define PG8_SCHED __builtin_amdgcn_sched_barrier(0)
    Unit cur, nxt; int ui = 0;
    if (!S.next(0, cur)) return;
    f32x4 acc[2][2][4][2];
#pragma unroll
    for (int a = 0; a < 2; ++a)
#pragma unroll
        for (int b = 0; b < 2; ++b)
#pragma unroll
            for (int m = 0; m < 4; ++m)
#pragma unroll
                for (int n = 0; n < 2; ++n) acc[a][b][m][n] = (f32x4){0.f, 0.f, 0.f, 0.f};
    bf16x8 At[4][2], B0[2][2], B1[2][2];
    const char* cA = (const char*)g.A + (size_t)cur.pm * tstep; const char* cB = (const char*)g.Bt + (size_t)cur.pn * tstep;
    S.a_ready(cur);
    if constexpr (SP2) {
        PG8_STAGE(PG8_SB(0, 0), cB, voffB); PG8_STAGE(PG8_SB(0, 1), cB + hstep, voffB); PG8_STAGE(PG8_SA(0, 0), cA, voffA); PG8_STAGE(PG8_SA(0, 1), cA + hstep, voffA);
        if (wr == 1) PG8_BAR;
        PG8_WAIT_V(2); PG8_BAR;
        PG8_STAGE(PG8_SB(1, 0), cB + kstep, voffB); PG8_STAGE(PG8_SA(1, 0), cA + kstep, voffA); PG8_STAGE(PG8_SB(1, 1), cB + hstep + kstep, voffB);
        PG8_WAIT_V(6); PG8_BAR;
    } else {
        PG8_STAGE(PG8_SB(0, 0), cB, voffB); PG8_STAGE(PG8_SA(0, 0), cA, voffA); PG8_STAGE(PG8_SB(0, 1), cB + hstep, voffB); PG8_STAGE(PG8_SA(0, 1), cA + hstep, voffA);
        if (wr == 1) PG8_BAR;
        PG8_WAIT_V(4); PG8_BAR;
        PG8_STAGE(PG8_SB(1, 0), cB + kstep, voffB); PG8_STAGE(PG8_SA(1, 0), cA + kstep, voffA); PG8_STAGE(PG8_SB(1, 1), cB + hstep + kstep, voffB);
        PG8_WAIT_V(6); PG8_BAR;
    }
    for (;;) {
        const bool has_next = S.next(ui + 1, nxt);
        const char* nA = has_next ? (const char*)g.A + (size_t)nxt.pm * tstep : cA; const char* nB = has_next ? (const char*)g.Bt + (size_t)nxt.pn * tstep : cB;
        for (int t = 0; t < nt; t += 2) {
            const bool last = (t == nt - 2);
            const char* a1 = cA + (size_t)(t + 1) * kstep;
            const char* a2 = last ? nA : cA + (size_t)(t + 2) * kstep; const char* b2 = last ? nB : cB + (size_t)(t + 2) * kstep;
            const char* a3 = a2 + kstep; const char* b3 = b2 + kstep;
            if (last && has_next) S.a_ready(nxt);
            if constexpr (SP2) {
            PG8_LDB(B0, 0, 0); PG8_LDB(B1, 0, 1); PG8_SCHED; PG8_LDA(At, 0, 0); PG8_STAGE(PG8_SA(1, 1), a1 + hstep, voffA);
            PG8_WAIT_V(8); PG8_WAIT_L(0); PG8_BAR; PG8_MMA(0, 0, At, B0); PG8_MMA(0, 1, At, B1); PG8_BAR; PG8_SCHED;
            PG8_LDA(At, 0, 1); PG8_STAGE(PG8_SB(0, 0), b2, voffB); PG8_STAGE(PG8_SB(0, 1), b2 + hstep, voffB); PG8_STAGE(PG8_SA(0, 0), a2, voffA);
            PG8_WAIT_V(8); PG8_WAIT_L(0); PG8_BAR; PG8_MMA(1, 0, At, B0); PG8_MMA(1, 1, At, B1); PG8_BAR; PG8_SCHED;
            PG8_LDB(B0, 1, 0); PG8_LDB(B1, 1, 1); PG8_SCHED; PG8_LDA(At, 1, 0); PG8_STAGE(PG8_SA(0, 1), a2 + hstep, voffA);
            PG8_WAIT_V(8); PG8_WAIT_L(0); PG8_BAR; PG8_MMA(0, 0, At, B0); PG8_MMA(0, 1, At, B1); PG8_BAR; PG8_SCHED;
            PG8_LDA(At, 1, 1); PG8_STAGE(PG8_SB(1, 0), b3, voffB); PG8_STAGE(PG8_SB(1, 1), b3 + hstep, voffB); PG8_STAGE(PG8_SA(1, 0), a3, voffA);
            PG8_WAIT_V(8); PG8_WAIT_L(0); PG8_BAR; PG8_MMA(1, 0, At, B0); PG8_MMA(1, 1, At, B1); PG8_BAR; PG8_SCHED;
            } else {
            PG8_LDB(B0, 0, 0); PG8_SCHED; PG8_LDA(At, 0, 0); PG8_STAGE(PG8_SA(1, 1), a1 + hstep, voffA);
            PG8_WAIT_L(8); PG8_BAR; PG8_WAIT_L(0); PG8_MMA(0, 0, At, B0); PG8_BAR; PG8_SCHED;
            PG8_LDB(B1, 0, 1); PG8_STAGE(PG8_SB(0, 0), b2, voffB);
            PG8_BAR; PG8_WAIT_L(0); PG8_MMA(0, 1, At, B1); PG8_BAR;
            PG8_LDA(At, 0, 1); PG8_STAGE(PG8_SA(0, 0), a2, voffA);
            PG8_BAR; PG8_WAIT_L(0); PG8_MMA(1, 0, At, B0); PG8_BAR; PG8_SCHED;
            PG8_STAGE(PG8_SB(0, 1), b2 + hstep, voffB);
            PG8_WAIT_V(6); PG8_BAR; PG8_MMA(1, 1, At, B1); PG8_BAR;
            PG8_LDB(B0, 1, 0); PG8_SCHED; PG8_LDA(At, 1, 0); PG8_STAGE(PG8_SA(0, 1), a2 + hstep, voffA);
            PG8_WAIT_L(8); PG8_BAR; PG8_WAIT_L(0); PG8_MMA(0, 0, At, B0); PG8_BAR; PG8_SCHED;
            PG8_LDB(B1, 1, 1); PG8_STAGE(PG8_SB(1, 0), b3, voffB);
            PG8_BAR; PG8_WAIT_L(0); PG8_MMA(0, 1, At, B1); PG8_BAR;
            PG8_LDA(At, 1, 1); PG8_STAGE(PG8_SA(1, 0), a3, voffA);
            PG8_BAR; PG8_WAIT_L(0); PG8_MMA(1, 0, At, B0); PG8_BAR; PG8_SCHED;
            PG8_STAGE(PG8_SB(1, 1), b3 + hstep, voffB);
            PG8_WAIT_V(6); PG8_BAR; PG8_MMA(1, 1, At, B1); PG8_BAR;
            }
        }
        if constexpr (ALIGN_EPI) { if (wr == 0) PG8_BAR; }
        if constexpr (!Epi::AFTER_DRAIN) { E(acc, cur, wr, wc, fr, fq); S.done(cur); }
        if (!has_next) break;
#pragma unroll
        for (int a = 0; a < 2; ++a)
#pragma unroll
            for (int b = 0; b < 2; ++b)
#pragma unroll
                for (int m = 0; m < 4; ++m)
#pragma unroll
                    for (int n = 0; n < 2; ++n) acc[a][b][m][n] = (f32x4){0.f, 0.f, 0.f, 0.f};
        cur = nxt; cA = nA; cB = nB; ++ui;
        if constexpr (ALIGN_EPI) { if (wr == 1) PG8_BAR; }
    }
    PG8_WAIT_V(0);
    if constexpr (!ALIGN_EPI) { if (wr == 0) PG8_BAR; }
    PG8_BAR;
    if constexpr (Epi::AFTER_DRAIN) { E.fused(acc, cur, wr, wc, fr, fq, lds, wid, lane); S.done(cur); }
#undef PG8_SA
#undef PG8_SB
#undef PG8_STAGE
#undef PG8_LDA
#undef PG8_LDB
#undef PG8_MMA
#undef PG8_WAIT_V
#undef PG8_WAIT_L
#undef PG8_BAR
#undef PG8_SCHED
}
}
#define XB_TMO      128
#define XB_XCNT(j)  (256  + 64 * (j))
#define XB_XSUB(j)  (1280 + 64 * (j))
#define XB_XGEN(j)  (2304 + 64 * (j))
#define XB_TOP      3328
#define XB_TOPGEN   3392
#define XCD_BAR_WORDS 3456
#define XB_SPIN_CAP (1u << 18)

__device__ __forceinline__ unsigned xb_ld(unsigned* p)              { return __hip_atomic_load(p, __ATOMIC_RELAXED, __HIP_MEMORY_SCOPE_AGENT); }
__device__ __forceinline__ unsigned xb_add(unsigned* p, unsigned v) { return __hip_atomic_fetch_add(p, v, __ATOMIC_RELAXED, __HIP_MEMORY_SCOPE_AGENT); }
__device__ __forceinline__ unsigned xb_xcc_id() { return (unsigned)__builtin_amdgcn_s_getreg((3 << 11) | 20) & 0xFu; }
#define XB_SPIN(cond, bar) do { unsigned _sp = 0; while (cond) { __builtin_amdgcn_s_sleep(1); \
    if ((++_sp & 255u) == 0u) { if (xb_ld(&(bar)[XB_TMO])) break; if (_sp > XB_SPIN_CAP) { atomicAdd(&(bar)[XB_TMO], 1u); break; } } } } while (0)

struct XcdBarrier {
    unsigned* bar; unsigned x;
    volatile LAS unsigned* st;
};

__device__ __forceinline__ XcdBarrier xcd_barrier_post(unsigned* bar, volatile LAS unsigned* st) {
    XcdBarrier b; b.bar = bar; b.x = xb_xcc_id(); b.st = st;
    if (threadIdx.x == 0) (void)xb_add(&bar[XB_XCNT(b.x)], 1u);
    return b;
}
__device__ __forceinline__ void xcd_barrier_complete(unsigned* bar, unsigned x, unsigned& nloc, unsigned& nx) {
    const unsigned G = gridDim.x * gridDim.y * gridDim.z;
    unsigned sum, cnt, mine, sp = 0u;
    for (;;) {
        sum = 0u; cnt = 0u; mine = 0u;
#pragma unroll
        for (unsigned j = 0; j < 16; ++j) { const unsigned c = xb_ld(&bar[XB_XCNT(j)]); sum += c; cnt += (c > 0u) ? 1u : 0u; mine = (j == x) ? c : mine; }
        if (sum == G) break;
        __builtin_amdgcn_s_sleep(1);
        if ((++sp & 255u) == 0u) { if (xb_ld(&bar[XB_TMO])) break; if (sp > XB_SPIN_CAP) { atomicAdd(&bar[XB_TMO], 1u); break; } }
    }
    nloc = mine > 0u ? mine : 1u; nx = cnt > 0u ? cnt : 1u;
}

__device__ __forceinline__ void xcd_barrier(const XcdBarrier& b) {
    asm volatile("s_waitcnt vmcnt(0)" ::: "memory");
    __syncthreads();
    if (threadIdx.x == 0) {
        unsigned* bar = b.bar;
        __builtin_amdgcn_s_waitcnt(0);
        unsigned nloc = b.st[0], nx = b.st[1];
        if (nloc == 0u) { xcd_barrier_complete(bar, b.x, nloc, nx); b.st[0] = nloc; b.st[1] = nx; }
        const unsigned old = xb_add(&bar[XB_XSUB(b.x)], 1u);
        const unsigned gen = old / nloc;
        if (old + 1u == (gen + 1u) * nloc) {
            __builtin_amdgcn_fence(__ATOMIC_RELEASE, "agent");
            asm volatile("s_waitcnt vmcnt(0)" ::: "memory");
            const unsigned og = xb_add(&bar[XB_TOP], 1u);
            const unsigned tg = og / nx;
            if (og + 1u == (tg + 1u) * nx) xb_add(&bar[XB_TOPGEN], 1u);
            else XB_SPIN(xb_ld(&bar[XB_TOPGEN]) == tg, bar);
            __builtin_amdgcn_fence(__ATOMIC_ACQUIRE, "agent");
            xb_add(&bar[XB_XGEN(b.x)], 1u);
            asm volatile("s_waitcnt vmcnt(0)" ::: "memory");
        } else {
            XB_SPIN(xb_ld(&bar[XB_XGEN(b.x)]) == gen, bar);
            __builtin_amdgcn_fence(__ATOMIC_ACQUIRE, "agent");
            asm volatile("s_waitcnt vmcnt(0)" ::: "memory");
        }
    }
    __syncthreads();
}

#ifndef MK_DUP
#define MK_DUP 0
#endif
#ifndef MK_SGB
#define MK_SGB 0
#endif
#ifndef MK_SKEW0
#define MK_SKEW0 0
#define MK_SKEW1 0
#endif
#ifndef MK_MULTI
#define MK_MULTI 0
#endif
constexpr int BATCH = 16, SEQ = 2048, D = 1024, H = 16, HD = 64, FF = 2816, DEPTH = 2, NREL = 192;
constexpr int M = BATCH * SEQ;
constexpr float RMS_EPS = 1e-6f;
constexpr float LOG2E = 1.4426950408889634f;
constexpr float C2 = 0.125f * LOG2E;
constexpr int NPH = 1 + 7 * DEPTH;
constexpr size_t MiB = 1u << 20;
constexpr size_t W_LAYER = 25 * MiB;
constexpr size_t W_QKV = 0, W_O = 6 * MiB, W_13 = 8 * MiB, W_2 = 19 * MiB;
constexpr size_t WS_XN = 64 * MiB, WS_Q = 128 * MiB, WS_K = 192 * MiB, WS_VT = 256 * MiB, WS_O = 320 * MiB, WS_MB = 384 * MiB, WS_END = 448 * MiB;
constexpr size_t WS_H = WS_Q;
static_assert(W_LAYER * DEPTH <= WS_XN && (size_t)M * FF * 2 <= WS_O - WS_H, "d_ws map");
constexpr size_t WS_CTL = 56 * MiB;
constexpr int MISC_OFF = 131072, LDS_BYTES = 131072 + 256;

typedef pg8::bf16_t bf16_t;
typedef short bf16x8 __attribute__((ext_vector_type(8)));
typedef float f32x16 __attribute__((ext_vector_type(16)));
typedef float f32x4 __attribute__((ext_vector_type(4)));
typedef unsigned u32x4 __attribute__((ext_vector_type(4)));
typedef unsigned u32x2 __attribute__((ext_vector_type(2)));

__device__ __forceinline__ unsigned cvtpk(float lo, float hi) { typedef float f2 __attribute__((ext_vector_type(2))); typedef __bf16 b2 __attribute__((ext_vector_type(2)));
    f2 v = {lo, hi}; b2 b = __builtin_convertvector(v, b2); return __builtin_bit_cast(unsigned, b); }
__device__ __forceinline__ float bflo(unsigned w) { return __uint_as_float(w << 16); }
__device__ __forceinline__ float bfhi(unsigned w) { return __uint_as_float(w & 0xffff0000u); }
__device__ __forceinline__ float wave_sum(float v) {
#pragma unroll
    for (int o = 1; o < 64; o <<= 1) v += __shfl_xor(v, o);
    return v;
}
__device__ __forceinline__ float ex2(float v) { return __builtin_amdgcn_exp2f(v); }
__device__ __forceinline__ float lg2(float v) { return __builtin_amdgcn_logf(v); }

struct EpiSwiGLU {
    static constexpr bool PERM = true, AFTER_DRAIN = false;
    bf16_t* O; int ldc;
    __device__ __forceinline__ void operator()(const pg8::f32x4 (&acc)[2][2][4][2], const pg8::Unit& u, int wr, int wc, int fr, int fq) const {
        const int row0 = u.pm * pg8::BM + wr * 64 + fr, col0 = u.pn * pg8::HALF + wc * 32 + 8 * fq;
#pragma unroll
        for (int ai = 0; ai < 2; ++ai)
#pragma unroll
            for (int m = 0; m < 4; ++m) {
                bf16_t* rowp = O + (size_t)(row0 + ai * pg8::HALF + m * 16) * ldc + col0;
                float hv[8];
#pragma unroll
                for (int n = 0; n < 2; ++n)
#pragma unroll
                    for (int t = 0; t < 4; ++t) { const float g = acc[ai][0][m][n][t], up = acc[ai][1][m][n][t];
                        hv[4 * n + t] = g * __builtin_amdgcn_rcpf(1.0f + ex2(-g * LOG2E)) * up; }
                u32x4 w; w.x = cvtpk(hv[0], hv[1]); w.y = cvtpk(hv[2], hv[3]); w.z = cvtpk(hv[4], hv[5]); w.w = cvtpk(hv[6], hv[7]);
                *(u32x4*)rowp = w;
            }
    }
};

struct GuOrder : pg8::StaticOrder {
    __device__ bool next(int i, pg8::Unit& u) const {
        if (G != 256) return pg8::StaticOrder::next(i, u);
        const int L = i * G + c; if (L >= nwg) return false;
        const int xcd = L & 7, off = L >> 3;
        int pl, pn;
        if (off < 256) { const int ch = off >> 7, o = off & 127; pl = 4 * (o >> 5) + (o & 3); pn = 8 * ch + ((o & 31) >> 2); }
        else { const int o = off - 256; pl = 4 * (o / 24) + (o % 24) % 4; pn = 16 + (o % 24) / 4; }
        u.pm = 8 * pl + xcd; u.pn = pn; return true;
    }
};
__device__ __forceinline__ void transpose_item(const float* W, int K, int N, bf16_t* WT, int k0, int n0, int dst_row0, LAS float* scr, int lane) {
    float wv[32];
#pragma unroll
    for (int i = 0; i < 32; ++i) wv[i] = __builtin_nontemporal_load(W + (size_t)(k0 + 2 * i + (lane >> 5)) * N + n0 + (lane & 31));
#pragma unroll
    for (int i = 0; i < 32; ++i) scr[(2 * i + (lane >> 5)) * 33 + (lane & 31)] = wv[i];
    asm volatile("s_waitcnt lgkmcnt(0)" ::: "memory");
    const int c = lane & 7;
#pragma unroll
    for (int j = 0; j < 4; ++j) { const int n = (lane >> 3) + 8 * j; const LAS float* s = scr + (8 * c) * 33 + n;
        u32x4 o; o.x = cvtpk(s[0 * 33], s[1 * 33]); o.y = cvtpk(s[2 * 33], s[3 * 33]); o.z = cvtpk(s[4 * 33], s[5 * 33]); o.w = cvtpk(s[6 * 33], s[7 * 33]);
        *(u32x4*)(WT + (size_t)(dst_row0 + n) * K + k0 + 8 * c) = o; }
    asm volatile("s_waitcnt lgkmcnt(0)" ::: "memory");
}

#define RP_SS(v) ((v.x * v.x + v.y * v.y) + (v.z * v.z + v.w * v.w))
#define RP_DEC(w) ((f32x4){bflo(w.x), bfhi(w.x), bflo(w.y), bfhi(w.y)})
__device__ __forceinline__ void row_phase(const float* xin, const bf16_t* mA, const float* gA, const bf16_t* mB, const float* gB, float* xout, bf16_t* xn, const float* gq_, int gw, int ngw, int lane) {
    asm volatile("" : "+v"(lane));
    const f32x4 z4 = {0.f, 0.f, 0.f, 0.f};
    f32x4 ga[4], gb[4], gq[4];
#pragma unroll
    for (int j = 0; j < 4; ++j) { ga[j] = mA ? *((const f32x4*)gA + lane + 64 * j) : z4; gb[j] = mB ? *((const f32x4*)gB + lane + 64 * j) : z4; gq[j] = xn ? *((const f32x4*)gq_ + lane + 64 * j) : z4; }
    int row = gw;
    for (; row + ngw < M; row += 2 * ngw) {
        const size_t o0 = (size_t)row * D, o1 = (size_t)(row + ngw) * D;
        f32x4 va[4], vb[4]; u32x2 wa[4], wb[4], ya[4], yb[4];
#pragma unroll
        for (int j = 0; j < 4; ++j) { va[j] = __builtin_nontemporal_load((const f32x4*)(xin + o0) + lane + 64 * j); vb[j] = __builtin_nontemporal_load((const f32x4*)(xin + o1) + lane + 64 * j); }
        if (mA) {
#pragma unroll
            for (int j = 0; j < 4; ++j) { wa[j] = __builtin_nontemporal_load((const u32x2*)(mA + o0) + lane + 64 * j); wb[j] = __builtin_nontemporal_load((const u32x2*)(mA + o1) + lane + 64 * j); } }
        if (mB) {
#pragma unroll
            for (int j = 0; j < 4; ++j) { ya[j] = __builtin_nontemporal_load((const u32x2*)(mB + o0) + lane + 64 * j); yb[j] = __builtin_nontemporal_load((const u32x2*)(mB + o1) + lane + 64 * j); } }
        if (mA) {
            f32x4 ea[4], eb[4]; float sa = 0.f, sb = 0.f;
#pragma unroll
            for (int j = 0; j < 4; ++j) { ea[j] = RP_DEC(wa[j]); eb[j] = RP_DEC(wb[j]); sa += RP_SS(ea[j]); sb += RP_SS(eb[j]); }
            const float ra = 1.0f / sqrtf(wave_sum(sa) * (1.0f / D) + RMS_EPS), rb = 1.0f / sqrtf(wave_sum(sb) * (1.0f / D) + RMS_EPS);
#pragma unroll
            for (int j = 0; j < 4; ++j) { va[j] = va[j] + ea[j] * ra * ga[j]; vb[j] = vb[j] + eb[j] * rb * ga[j]; }
        }
        if (mB) {
            f32x4 ea[4], eb[4]; float sa = 0.f, sb = 0.f;
#pragma unroll
            for (int j = 0; j < 4; ++j) { ea[j] = RP_DEC(ya[j]); eb[j] = RP_DEC(yb[j]); sa += RP_SS(ea[j]); sb += RP_SS(eb[j]); }
            const float ra = 1.0f / sqrtf(wave_sum(sa) * (1.0f / D) + RMS_EPS), rb = 1.0f / sqrtf(wave_sum(sb) * (1.0f / D) + RMS_EPS);
#pragma unroll
            for (int j = 0; j < 4; ++j) { va[j] = va[j] + ea[j] * ra * gb[j]; vb[j] = vb[j] + eb[j] * rb * gb[j]; }
        }
        if (xout) {
#pragma unroll
            for (int j = 0; j < 4; ++j) { __builtin_nontemporal_store(va[j], (f32x4*)(xout + o0) + lane + 64 * j); __builtin_nontemporal_store(vb[j], (f32x4*)(xout + o1) + lane + 64 * j); } }
        if (xn) {
            float sa = 0.f, sb = 0.f;
#pragma unroll
            for (int j = 0; j < 4; ++j) { sa += RP_SS(va[j]); sb += RP_SS(vb[j]); }
            const float ra = 1.0f / sqrtf(wave_sum(sa) * (1.0f / D) + RMS_EPS), rb = 1.0f / sqrtf(wave_sum(sb) * (1.0f / D) + RMS_EPS);
#pragma unroll
            for (int j = 0; j < 4; ++j) { const f32x4 p = va[j] * ra * gq[j], q2 = vb[j] * rb * gq[j]; u32x2 w; w.x = cvtpk(p.x, p.y); w.y = cvtpk(p.z, p.w); ((u32x2*)(xn + o0) + lane)[64 * j] = w;
                w.x = cvtpk(q2.x, q2.y); w.y = cvtpk(q2.z, q2.w); ((u32x2*)(xn + o1) + lane)[64 * j] = w; }
        }
    }
    for (; row < M; row += ngw) {
        const size_t o0 = (size_t)row * D;
        f32x4 va[4];
#pragma unroll
        for (int j = 0; j < 4; ++j) va[j] = ((const f32x4*)(xin + o0) + lane)[64 * j];
        if (mA) { f32x4 ea[4]; float sa = 0.f;
#pragma unroll
            for (int j = 0; j < 4; ++j) { const u32x2 w = ((const u32x2*)(mA + o0) + lane)[64 * j]; ea[j] = RP_DEC(w); sa += RP_SS(ea[j]); }
            const float ra = 1.0f / sqrtf(wave_sum(sa) * (1.0f / D) + RMS_EPS);
#pragma unroll
            for (int j = 0; j < 4; ++j) va[j] = va[j] + ea[j] * ra * ga[j]; }
        if (mB) { f32x4 ea[4]; float sa = 0.f;
#pragma unroll
            for (int j = 0; j < 4; ++j) { const u32x2 w = ((const u32x2*)(mB + o0) + lane)[64 * j]; ea[j] = RP_DEC(w); sa += RP_SS(ea[j]); }
            const float ra = 1.0f / sqrtf(wave_sum(sa) * (1.0f / D) + RMS_EPS);
#pragma unroll
            for (int j = 0; j < 4; ++j) va[j] = va[j] + ea[j] * ra * gb[j]; }
        if (xout) {
#pragma unroll
            for (int j = 0; j < 4; ++j) ((f32x4*)(xout + o0) + lane)[64 * j] = va[j]; }
        if (xn) { float sa = 0.f;
#pragma unroll
            for (int j = 0; j < 4; ++j) sa += RP_SS(va[j]);
            const float ra = 1.0f / sqrtf(wave_sum(sa) * (1.0f / D) + RMS_EPS);
#pragma unroll
            for (int j = 0; j < 4; ++j) { const f32x4 p = va[j] * ra * gq[j]; u32x2 w; w.x = cvtpk(p.x, p.y); w.y = cvtpk(p.z, p.w); ((u32x2*)(xn + o0) + lane)[64 * j] = w; } }
    }
}
#undef RP_SS
#undef RP_DEC

__device__ __forceinline__ int pi32(int i) { return (i & 0x13) | ((i & 4) << 1) | ((i & 8) >> 1); }
#define MFMA32(a, b, c) __builtin_amdgcn_mfma_f32_32x32x16_bf16((a), (b), (c), 0, 0, 0)
constexpr int TILE_B = 16384, NBUF = 5, ATT_TAB_OFF = NBUF * TILE_B;
static_assert(ATT_TAB_OFF + 3 * 2 * 8 * 64 * 16 <= MISC_OFF, "attention LDS map");
struct TileLd { u32x4 k, v; };
__device__ __forceinline__ void tile_issue(TileLd& r, const bf16_t* Kg, const bf16_t* Vg, int tau) {
    r.k = *(const u32x4*)(Kg + (size_t)tau * 64 * D); r.v = *(const u32x4*)(Vg + tau * 64);
}
__device__ __forceinline__ void tile_commit(LAS unsigned char* ring, int buf, unsigned woff, const TileLd& r) {
    *(LAS u32x4*)(ring + buf * TILE_B + woff) = r.k; *(LAS u32x4*)(ring + buf * TILE_B + 8192 + woff) = r.v;
}
__device__ __forceinline__ void frag_k(bf16x8 (&kf)[2][4], const LAS unsigned char* tb, const unsigned (&fa)[4]) {
#pragma unroll
    for (int kvh = 0; kvh < 2; ++kvh)
#pragma unroll
        for (int d0 = 0; d0 < 4; ++d0) kf[kvh][d0] = *(const LAS bf16x8*)(tb + kvh * 4096 + fa[d0]);
}
__device__ __forceinline__ void frag_v(bf16x8 (&vf)[2][4], const LAS unsigned char* tb, const unsigned (&fa)[4]) {
#pragma unroll
    for (int db = 0; db < 2; ++db)
#pragma unroll
        for (int kb = 0; kb < 4; ++kb) vf[db][kb] = *(const LAS bf16x8*)(tb + 8192 + db * 4096 + fa[kb]);
}
template <int B0> __device__ __forceinline__ bf16x8 pack8(const f32x16& p) {
    u32x4 w; w.x = cvtpk(p[B0], p[B0 + 1]); w.y = cvtpk(p[B0 + 2], p[B0 + 3]); w.z = cvtpk(p[B0 + 4], p[B0 + 5]); w.w = cvtpk(p[B0 + 6], p[B0 + 7]);
    return __builtin_bit_cast(bf16x8, w);
}
__device__ __forceinline__ void qk_tile(f32x16& p0, f32x16& p1, const bf16x8 (&kf)[2][4], const bf16x8 (&qr)[4]) {
#pragma unroll
    for (int d0 = 0; d0 < 4; ++d0) { p0 = MFMA32(kf[0][d0], qr[d0], p0); p1 = MFMA32(kf[1][d0], qr[d0], p1); }
}
__device__ __forceinline__ void pv_tile(f32x16& o0, f32x16& o1, const bf16x8 (&vf)[2][4], const f32x16& p0, const f32x16& p1) {
    const bf16x8 pw0 = pack8<0>(p0), pw1 = pack8<8>(p0), pw2 = pack8<0>(p1), pw3 = pack8<8>(p1);
    o0 = MFMA32(vf[0][0], pw0, o0); o1 = MFMA32(vf[1][0], pw0, o1);
    o0 = MFMA32(vf[0][1], pw1, o0); o1 = MFMA32(vf[1][1], pw1, o1);
    o0 = MFMA32(vf[0][2], pw2, o0); o1 = MFMA32(vf[1][2], pw2, o1);
    o0 = MFMA32(vf[0][3], pw3, o0); o1 = MFMA32(vf[1][3], pw3, o1);
}
__device__ __forceinline__ void store_o(bf16_t* Op, const f32x16& o0, const f32x16& o1, float sc) {
    const f32x16 a = o0 * sc, b = o1 * sc;
    *(bf16x8*)(Op + 0) = pack8<0>(a); *(bf16x8*)(Op + 16) = pack8<8>(a); *(bf16x8*)(Op + 32) = pack8<0>(b); *(bf16x8*)(Op + 48) = pack8<8>(b);
}
__device__ __forceinline__ void gload16(u32x4& dst, const void* p) { asm volatile("global_load_dwordx4 %0, %1, off" : "=&v"(dst) : "v"(p) : "memory"); }
constexpr int N_ITEMS = BATCH * H * 8;

__device__ __forceinline__ void item_decode(int it, int& bh, int& grp) {
    if (gridDim.x == 256) { const int i = it >> 8, x = blockIdx.x & 7, m = blockIdx.x >> 3, qq = m >> 3; bh = (8 * (qq >> 1) + i) * H + 2 * x + (qq & 1); grp = ((m & 7) + i) & 7; }
    else { bh = it >> 3; grp = ((it & 7) + (it >> 8)) & 7; }
}
__device__ __forceinline__ void attn0_phase(LAS unsigned char* lds, const bf16_t* Q, const bf16_t* K, const bf16_t* Vt, bf16_t* O, const float* relb, int tid, int lane, int wave) {
    asm volatile("" : "+v"(tid), "+v"(lane));
    LAS f32x4* tab = (LAS f32x4*)(lds + ATT_TAB_OFF);
    const int q = lane & 31, hi = lane >> 5, j = wave >> 1, hf = wave & 1;
    const int R = tid >> 3, cc = tid & 7, wslot = (R & 32) | pi32(R & 31);
    const unsigned woff = (unsigned)(wslot * 128 + ((cc ^ ((wslot >> 1) & 7)) << 4));
    unsigned fa[4];
#pragma unroll
    for (int t = 0; t < 4; ++t) fa[t] = (unsigned)(q * 128 + (((2 * t + hi) ^ ((q >> 1) & 7)) << 4));
    int cur_h = -1; float cfar = 0.f;
    for (int it = blockIdx.x; it < N_ITEMS; it += gridDim.x) {
        int bh, grp; item_decode(it, bh, grp);
        const int c0 = grp * 4, b = bh / H, h = bh % H, c = c0 + j;
        if (h != cur_h) {
            for (int e = tid; e < 3 * 2 * 8 * 64; e += 512) {
                const int ln = e & 63, g = (e >> 6) & 7, ehf = (e >> 9) & 1, dl = e >> 10;
                const int qi = 32 * ehf + (ln & 31), lhi = ln >> 5;
                f32x4 v;
#pragma unroll
                for (int t = 0; t < 4; ++t) { const int rr = 4 * g + t, pp = rr >> 4, r = rr & 15, kvi = 32 * pp + 16 * (r >> 3) + 8 * lhi + (r & 7);
                    int rel = 64 * dl + qi - kvi; rel = rel < -63 ? -63 : (rel > 128 ? 128 : rel); v[t] = relb[h * NREL + rel + 63] * LOG2E; }
                tab[e] = v;
            }
            cfar = relb[h * NREL + NREL - 1] * LOG2E; cur_h = h;
        }
        const bf16_t* Kg = K + (size_t)(b * SEQ + R) * D + h * HD + cc * 8;
        const bf16_t* Vg = Vt + (size_t)(h * HD + R) * M + (size_t)b * SEQ + cc * 8;
        const int q0 = c * 64 + hf * 32;
        const bf16_t* Qp = Q + (size_t)(b * SEQ + q0 + q) * D + h * HD + hi * 8;
        bf16x8 qr[4];
#pragma unroll
        for (int d0 = 0; d0 < 4; ++d0) qr[d0] = __builtin_nontemporal_load((const bf16x8*)(Qp + d0 * 16));
        {
            TileLd pl[4];
#pragma unroll
            for (int k = 0; k < 4; ++k) { const int tau = c0 - 8 + k; tile_issue(pl[k], Kg, Vg, tau < 0 ? 0 : tau); }
#pragma unroll
            for (int k = 0; k < 4; ++k) { const int tau = c0 - 8 + k; tile_commit(lds, (tau + 15) % NBUF, woff, pl[k]); }
        }
        float m_run = -INFINITY, l_run = 0.f; f32x16 o0 = {}, o1 = {};
        u32x4 rka, rva, rkb, rvb;
        { const int t0 = c0 - 4 < 0 ? 0 : c0 - 4; gload16(rka, Kg + (size_t)t0 * 64 * D); gload16(rva, Vg + t0 * 64); }
        __syncthreads();
#define A0_STEP(S, CK, CV, NK, NV, LOADNEXT) do { \
            const int pre = c0 - 4 + (S); const bool do_pre = ((S) < 8) && (pre >= 0); \
            if (LOADNEXT) { int t1 = pre + 1; t1 = t1 < 0 ? 0 : (t1 > c0 + 3 ? c0 + 3 : t1); gload16(NK, Kg + (size_t)t1 * 64 * D); gload16(NV, Vg + t1 * 64); }     \
            const int tau = c - 8 + (S); \
            if (MK_SKEW0 && wave >= 4) __builtin_amdgcn_s_sleep(MK_SKEW0); \
            if (tau >= 0) { \
                const LAS unsigned char* tb = lds + ((tau + 15) % NBUF) * TILE_B; \
                const int dl = 8 - (S); \
                bf16x8 kf[2][4], vf[2][4]; \
                frag_k(kf, tb, fa); \
                f32x16 p0 = {}, p1 = {}; \
                float cb = cfar; \
                if (dl <= 2) { const LAS f32x4* tp = tab + ((dl * 2 + hf) * 8) * 64 + lane; cb = 0.f; \
                    _Pragma("unroll") for (int g = 0; g < 4; ++g) { const f32x4 a = tp[g * 64], bb = tp[(g + 4) * 64]; \
                        _Pragma("unroll") for (int t = 0; t < 4; ++t) { p0[4 * g + t] = a[t]; p1[4 * g + t] = bb[t]; } } \
                } \
                qk_tile(p0, p1, kf, qr); \
                frag_v(vf, tb, fa); \
                float mx = fmaxf(p0[0], p1[0]); \
                _Pragma("unroll") for (int r = 1; r < 16; ++r) mx = fmaxf(mx, fmaxf(p0[r], p1[r])); \
                mx = fmaxf(mx, __shfl_xor(mx, 32)) + cb; \
                if (__any(mx > m_run)) { \
                    const float mn = fmaxf(m_run, mx), f = ex2(m_run - mn); m_run = mn; \
                    l_run *= f; o0 = o0 * f; o1 = o1 * f; \
                } \
                const float ms = m_run - cb; \
                float sm = 0.f; \
                _Pragma("unroll") for (int r = 0; r < 16; ++r) { p0[r] = ex2(p0[r] - ms); p1[r] = ex2(p1[r] - ms); sm += p0[r] + p1[r]; } \
                l_run += sm; \
                pv_tile(o0, o1, vf, p0, p1); \
            } \
            if (LOADNEXT) asm volatile("s_waitcnt vmcnt(2)" : "+v"(CK), "+v"(CV) :: "memory");     \
            else asm volatile("s_waitcnt vmcnt(0)" : "+v"(CK), "+v"(CV) :: "memory"); \
            if (do_pre) { *(LAS u32x4*)(lds + ((pre + 15) % NBUF) * TILE_B + woff) = CK; *(LAS u32x4*)(lds + ((pre + 15) % NBUF) * TILE_B + 8192 + woff) = CV; } \
            __syncthreads(); \
        } while (0)
#pragma unroll 1
        for (int s = 0; s < 6; s += 2) { A0_STEP(s, rka, rva, rkb, rvb, 1); A0_STEP(s + 1, rkb, rvb, rka, rva, 1); }
        A0_STEP(6, rka, rva, rkb, rvb, 1);
        A0_STEP(7, rkb, rvb, rka, rva, 0);
        A0_STEP(8, rka, rva, rkb, rvb, 0);
#undef A0_STEP
        const float l = l_run + __shfl_xor(l_run, 32);
        store_o(O + (size_t)(b * SEQ + q0 + q) * D + h * HD + hi * 8, o0, o1, 1.0f / l);
    }
}

__device__ __forceinline__ void attn1_phase(LAS unsigned char* lds, const bf16_t* Q, const bf16_t* K, const bf16_t* Vt, bf16_t* O, int tid, int lane, int wave) {
    asm volatile("" : "+v"(tid), "+v"(lane));
    const int q = lane & 31, hi = lane >> 5, j = wave >> 1, hf = wave & 1;
    const int R = tid >> 3, cc = tid & 7, wslot = (R & 32) | pi32(R & 31);
    const unsigned woff = (unsigned)(wslot * 128 + ((cc ^ ((wslot >> 1) & 7)) << 4));
    unsigned fa[4];
#pragma unroll
    for (int t = 0; t < 4; ++t) fa[t] = (unsigned)(q * 128 + (((2 * t + hi) ^ ((q >> 1) & 7)) << 4));
    const int trel = 32 * hf + q;
    for (int it = blockIdx.x; it < N_ITEMS; it += gridDim.x) {
        int bh, grp; item_decode(it, bh, grp);
        const int c0 = grp * 4, b = bh / H, h = bh % H, T = c0 + j;
        const bf16_t* Kg = K + (size_t)(b * SEQ + R) * D + h * HD + cc * 8;
        const bf16_t* Vg = Vt + (size_t)(h * HD + R) * M + (size_t)b * SEQ + cc * 8;
        const int q0 = T * 64 + hf * 32;
        const bf16_t* Qp = Q + (size_t)(b * SEQ + q0 + q) * D + h * HD + hi * 8;
        bf16x8 qr[4];
#pragma unroll
        for (int d0 = 0; d0 < 4; ++d0) qr[d0] = __builtin_nontemporal_load((const bf16x8*)(Qp + d0 * 16));
        {
            TileLd pl[4];
#pragma unroll
            for (int k = 0; k < 4; ++k) tile_issue(pl[k], Kg, Vg, c0 + k);
#pragma unroll
            for (int k = 0; k < 4; ++k) tile_commit(lds, (c0 + k) % NBUF, woff, pl[k]);
        }
        float carry = 1.0f; f32x16 o0 = {}, o1 = {}; bool done = false;
        u32x4 rka, rva, rkb, rvb;
        { const int t0 = c0 - 1 < 0 ? 0 : c0 - 1; gload16(rka, Kg + (size_t)t0 * 64 * D); gload16(rva, Vg + t0 * 64); }
        __syncthreads();
        bool more = true;
#define A1_STEP(S, CK, CV, NK, NV) do { \
            const int pre = c0 - (S) - 1; const bool do_pre = pre >= 0; \
            { const int t1 = pre - 1 < 0 ? 0 : pre - 1; gload16(NK, Kg + (size_t)t1 * 64 * D); gload16(NV, Vg + t1 * 64); } \
            const int tau = T - (S); \
            if (MK_SKEW1 && wave >= 4) __builtin_amdgcn_s_sleep(MK_SKEW1); \
            if (!done) { \
                const LAS unsigned char* tb = lds + (tau % NBUF) * TILE_B; \
                bf16x8 kf[2][4], vf[2][4]; \
                frag_k(kf, tb, fa); \
                f32x16 p0 = {}, p1 = {}; \
                qk_tile(p0, p1, kf, qr); \
                frag_v(vf, tb, fa); \
                const bool diag = ((S) == 0); \
                f32x16 r0, r1; \
                _Pragma("unroll") for (int r = 0; r < 16; ++r) { \
                    const int kvr = 16 * (r >> 3) + 8 * hi + (r & 7); \
                    { const float e = ex2(fminf(p0[r], 64.f)), rc = __builtin_amdgcn_rcpf(1.0f + e); const bool ok = !diag || (kvr < trel); r0[r] = ok ? rc : 1.0f; p0[r] = ok ? e * rc : 0.f; } \
                    { const float e = ex2(fminf(p1[r], 64.f)), rc = __builtin_amdgcn_rcpf(1.0f + e); const bool ok = !diag || (kvr + 32 < trel); r1[r] = ok ? rc : 1.0f; p1[r] = ok ? e * rc : 0.f; } \
                } \
                float Rn[4], Pn[4]; \
                Rn[0] = ((r0[0] * r0[1]) * (r0[2] * r0[3])) * ((r0[4] * r0[5]) * (r0[6] * r0[7])); \
                Rn[1] = ((r0[8] * r0[9]) * (r0[10] * r0[11])) * ((r0[12] * r0[13]) * (r0[14] * r0[15])); \
                Rn[2] = ((r1[0] * r1[1]) * (r1[2] * r1[3])) * ((r1[4] * r1[5]) * (r1[6] * r1[7])); \
                Rn[3] = ((r1[8] * r1[9]) * (r1[10] * r1[11])) * ((r1[12] * r1[13]) * (r1[14] * r1[15])); \
                _Pragma("unroll") for (int a = 0; a < 4; ++a) Pn[a] = __shfl_xor(Rn[a], 32); \
                float tail[4]; float after = carry; \
                _Pragma("unroll") for (int a = 3; a >= 0; --a) { tail[a] = after * (hi == 0 ? Pn[a] : 1.0f); after *= Rn[a] * Pn[a]; } \
                _Pragma("unroll") for (int a = 0; a < 2; ++a) { float s0 = tail[a], s1 = tail[a + 2]; \
                    _Pragma("unroll") for (int jj = 7; jj >= 0; --jj) { const int r = 8 * a + jj; p0[r] *= s0; s0 *= r0[r]; p1[r] *= s1; s1 *= r1[r]; } } \
                carry = after; \
                pv_tile(o0, o1, vf, p0, p1); \
                if (tau == 0 || __all(carry < 1e-37f)) done = true; \
            } \
            asm volatile("s_waitcnt vmcnt(2)" : "+v"(CK), "+v"(CV) :: "memory");     \
            if (do_pre) { *(LAS u32x4*)(lds + (pre % NBUF) * TILE_B + woff) = CK; *(LAS u32x4*)(lds + (pre % NBUF) * TILE_B + 8192 + woff) = CV; } \
            { LAS unsigned* vs_ = (LAS unsigned*)(lds + MISC_OFF + 32) + ((S) % 3) * 8;     \
              if (lane == 0) vs_[wave] = done ? 0u : 1u; \
              __syncthreads(); \
              const u32x4 f0_ = *(LAS u32x4*)vs_, f1_ = *(LAS u32x4*)(vs_ + 4); \
              more = ((f0_.x | f0_.y) | (f0_.z | f0_.w) | (f1_.x | f1_.y) | (f1_.z | f1_.w)) != 0u; } \
        } while (0)
#pragma unroll 1
        for (int s = 0; more; s += 2) { A1_STEP(s, rka, rva, rkb, rvb); if (!more) break; A1_STEP(s + 1, rkb, rvb, rka, rva); }
#undef A1_STEP
        asm volatile("s_waitcnt vmcnt(0)" ::: "memory");
        asm volatile("" :: "v"(rka), "v"(rva), "v"(rkb), "v"(rvb));
        store_o(O + (size_t)(b * SEQ + q0 + q) * D + h * HD + hi * 8, o0, o1, 1.0f);
    }
}

struct Args { const float* x; const float* g_pre_mix; const float* g_post_mix; const float* w_qkv; const float* w_o; const float* rel_bias;
              const float* g_pre_ffn; const float* g_post_ffn; const float* w_gate; const float* w_up; const float* w_down; float* out; unsigned char* ws; int ph_lo, ph_hi; };

__global__ void __launch_bounds__(512, 2) mega_fwd(Args a) {
    extern __shared__ __attribute__((aligned(16))) unsigned char lds_raw[];
    LAS unsigned char* lds = (LAS unsigned char*)lds_raw;
    const int tid = threadIdx.x, lane = tid & 63, wave = __builtin_amdgcn_readfirstlane(tid >> 6);
    const int G = gridDim.x, gw = blockIdx.x * 8 + wave, ngw = G * 8;
    unsigned char* ws = a.ws;
    bf16_t* XN = (bf16_t*)(ws + WS_XN); bf16_t* Qb = (bf16_t*)(ws + WS_Q); bf16_t* Kb = (bf16_t*)(ws + WS_K); bf16_t* Vt = (bf16_t*)(ws + WS_VT);
    bf16_t* Ob = (bf16_t*)(ws + WS_O); bf16_t* Mb = (bf16_t*)(ws + WS_MB); bf16_t* Hb = (bf16_t*)(ws + WS_H);
    bf16_t* Mb2 = Ob;

    const int lo = a.ph_lo, hi = a.ph_hi;
    volatile LAS unsigned* MISC = (volatile LAS unsigned*)(lds + MISC_OFF);
    unsigned* barw = (unsigned*)(ws + WS_CTL);
    if (tid < 2) MISC[tid] = 0u;
    __syncthreads();
    if (hi > NPH) cg::this_grid().sync();
    XcdBarrier bar = xcd_barrier_post(barw, MISC);
#define RUN(p) (lo <= (p) && (p) < hi)
#define SEAM(p) do { if (lo <= (p) && (p) + 1 < hi) xcd_barrier(bar); } while (0)
#define REP(bit) for (int rep_ = 0; rep_ < ((MK_DUP & (bit)) ? 2 : 1); ++rep_, ((MK_DUP & (bit)) && rep_ < 2 ? xcd_barrier(bar) : (void)0))
    if (RUN(0)) REP(64) {
        LAS float* scr = (LAS float*)(lds + wave * 16384);
        constexpr int I_QKV = (D / 64) * (3 * D / 32), I_O = (D / 64) * (D / 32), I_G = (D / 64) * (FF / 32), I_D = (FF / 64) * (D / 32);
        constexpr int I_LAYER = I_QKV + I_O + 2 * I_G + I_D;
        for (int it = gw; it < DEPTH * I_LAYER; it += ngw) {
            const int l = it / I_LAYER; int r = it % I_LAYER;
            unsigned char* wl = ws + (size_t)l * W_LAYER;
            if (r < I_QKV) { const int nblk = 3 * D / 32, kb = r / nblk, nb = r % nblk; transpose_item(a.w_qkv + (size_t)l * D * 3 * D, D, 3 * D, (bf16_t*)(wl + W_QKV), 64 * kb, 32 * nb, 32 * nb, scr, lane); continue; } r -= I_QKV;
            if (r < I_O) { const int nblk = D / 32, kb = r / nblk, nb = r % nblk; transpose_item(a.w_o + (size_t)l * D * D, D, D, (bf16_t*)(wl + W_O), 64 * kb, 32 * nb, 32 * nb, scr, lane); continue; } r -= I_O;
            if (r < 2 * I_G) { const int up = r >= I_G; if (up) r -= I_G; const int nblk = FF / 32, kb = r / nblk, nb = r % nblk, n0 = 32 * nb;
                transpose_item((up ? a.w_up : a.w_gate) + (size_t)l * D * FF, D, FF, (bf16_t*)(wl + W_13), 64 * kb, n0, 256 * (n0 >> 7) + (n0 & 127) + (up ? 128 : 0), scr, lane); continue; } r -= 2 * I_G;
            { const int nblk = D / 32, kb = r / nblk, nb = r % nblk; transpose_item(a.w_down + (size_t)l * FF * D, FF, D, (bf16_t*)(wl + W_2), 64 * kb, 32 * nb, 32 * nb, scr, lane); }
        }
        row_phase(a.x, nullptr, nullptr, nullptr, nullptr, nullptr, XN, a.g_pre_mix, gw, ngw, lane);
    }
    SEAM(0);
    for (int l = 0; l < DEPTH; ++l) {
        const int pb = 1 + 7 * l;
        unsigned char* wl = ws + (size_t)l * W_LAYER;
        if (RUN(pb + 0)) REP(1) {
            { pg8::Gemm g{XN, (const bf16_t*)(wl + W_QKV), M, 2 * D, D}; pg8::StaticOrder S; S.init(M, 2 * D, G, (int)blockIdx.x);
              pg8::EpiBf16<0> E{Qb, D, nullptr, D, (size_t)(WS_K - WS_Q) / 2, C2};
              pg8::gemm_phase<pg8::EpiBf16<0>, pg8::StaticOrder, true, true>(lds, g, S, E); }
            { pg8::Gemm g{(const bf16_t*)(wl + W_QKV) + (size_t)2 * D * D, XN, D, M, D}; pg8::StaticOrder S; S.init(D, M, G, (int)blockIdx.x);
              pg8::EpiBf16<0> E{Vt, M, nullptr, 0, 0, 1.f};
              pg8::gemm_phase<pg8::EpiBf16<0>, pg8::StaticOrder, true, true>(lds, g, S, E); }
        }
        SEAM(pb + 0);
        if (RUN(pb + 1)) REP((l & 1) ? 4 : 2) {
            if ((l & 1) == 0) attn0_phase(lds, Qb, Kb, Vt, Ob, a.rel_bias + (size_t)(l >> 1) * H * NREL, tid, lane, wave);
            else attn1_phase(lds, Qb, Kb, Vt, Ob, tid, lane, wave);
        }
        SEAM(pb + 1);
        if (RUN(pb + 2)) REP(8) {
            pg8::Gemm g{Ob, (const bf16_t*)(wl + W_O), M, D, D}; pg8::StaticOrder S; S.init(M, D, G, (int)blockIdx.x);
            pg8::EpiBf16<0> E{Mb, D, nullptr, 0, 0, 1.f};
            pg8::gemm_phase<pg8::EpiBf16<0>, pg8::StaticOrder, true, true>(lds, g, S, E);
        }
        SEAM(pb + 2);
        if (RUN(pb + 3))
            row_phase(l == 0 ? a.x : a.out, Mb, a.g_post_mix + (size_t)l * D, nullptr, nullptr, nullptr, XN, a.g_pre_ffn + (size_t)l * D, gw, ngw, lane);
        SEAM(pb + 3);
        if (RUN(pb + 4)) REP(16) {
            pg8::Gemm g{XN, (const bf16_t*)(wl + W_13), M, 2 * FF, D}; GuOrder S; S.init(M, 2 * FF, G, (int)blockIdx.x);
            EpiSwiGLU E{Hb, FF};
            pg8::gemm_phase<EpiSwiGLU, GuOrder, true, true>(lds, g, S, E);
        }
        SEAM(pb + 4);
        if (RUN(pb + 5)) REP(32) {
            pg8::Gemm g{Hb, (const bf16_t*)(wl + W_2), M, D, FF}; pg8::StaticOrder S; S.init(M, D, G, (int)blockIdx.x);
            pg8::EpiBf16<0> E{Mb2, D, nullptr, 0, 0, 1.f};
            pg8::gemm_phase<pg8::EpiBf16<0>, pg8::StaticOrder, true, true>(lds, g, S, E);
        }
        SEAM(pb + 5);
        if (RUN(pb + 6)) {
            const bool last = (l == DEPTH - 1);
            row_phase(l == 0 ? a.x : a.out, Mb, a.g_post_mix + (size_t)l * D, Mb2, a.g_post_ffn + (size_t)l * D, a.out, last ? nullptr : XN, last ? nullptr : a.g_pre_mix + (size_t)(l + 1) * D, gw, ngw, lane);
        }
        SEAM(pb + 6);
    }
#undef RUN
#undef SEAM
#undef REP
}

extern "C" void kernel_launch(void* const* d_in, const int* in_sizes, int n_in, void* d_out, int out_size, void* d_ws, size_t ws_size, hipStream_t stream) {
    static int grid = 0;
    if (grid == 0) {
        if (n_in != 11 || in_sizes[0] != M * D || out_size != M * D || ws_size < WS_END) { fprintf(stderr, "kernel_launch: unexpected shapes (n_in %d, in0 %d, out %d, ws %zu); nothing launched\n", n_in, n_in > 0 ? in_sizes[0] : -1, out_size, ws_size); grid = -1; return; }
        int dev = 0, cus = 0, per_cu = 0;
        if (hipGetDevice(&dev) != hipSuccess || hipDeviceGetAttribute(&cus, hipDeviceAttributeMultiprocessorCount, dev) != hipSuccess) { grid = -1; return; }
        if (hipFuncSetAttribute((const void*)mega_fwd, hipFuncAttributeMaxDynamicSharedMemorySize, LDS_BYTES) != hipSuccess) { fprintf(stderr, "kernel_launch: hipFuncSetAttribute failed\n"); grid = -1; return; }
        if (hipOccupancyMaxActiveBlocksPerMultiprocessor(&per_cu, (const void*)mega_fwd, 512, LDS_BYTES) != hipSuccess || per_cu < 1) { fprintf(stderr, "kernel_launch: occupancy query says %d\n", per_cu); per_cu = 1; }
        (void)hipGetLastError();
        grid = cus * per_cu;
    }
    if (grid < 0) return;
    Args a{};
    a.x = (const float*)d_in[0]; a.g_pre_mix = (const float*)d_in[1]; a.g_post_mix = (const float*)d_in[2]; a.w_qkv = (const float*)d_in[3]; a.w_o = (const float*)d_in[4]; a.rel_bias = (const float*)d_in[5];
    a.g_pre_ffn = (const float*)d_in[6]; a.g_post_ffn = (const float*)d_in[7]; a.w_gate = (const float*)d_in[8]; a.w_up = (const float*)d_in[9]; a.w_down = (const float*)d_in[10];
    a.out = (float*)d_out; a.ws = (unsigned char*)d_ws;
#if MK_MULTI
    for (int ph = 0; ph < NPH; ++ph) { a.ph_lo = ph; a.ph_hi = ph + 1; hipLaunchKernelGGL(mega_fwd, dim3(grid), dim3(512), LDS_BYTES, stream, a); }
#else
    a.ph_lo = 0; a.ph_hi = NPH;
    if (hipMemsetAsync((char*)d_ws + WS_CTL, 0, 16384, stream) != hipSuccess) { fprintf(stderr, "kernel_launch: hipMemsetAsync failed\n"); return; }
    void* args[] = {&a};
    const hipError_t e = hipLaunchCooperativeKernel((const void*)mega_fwd, dim3(grid), dim3(512), args, LDS_BYTES, stream);
    if (e != hipSuccess) fprintf(stderr, "kernel_launch: cooperative launch failed: %s (grid %d)\n", hipGetErrorString(e), grid);
#endif
}
```
